# Optimizing an MI355X kernel written in HIP

```python
import math
import jax, jax.numpy as jnp
from jax import lax
import numpy as np


D_MODEL = 2048
BATCH = 4
SEQ = 4096
DEPTH = 1

MIX_WIDTH = D_MODEL
HG_WIDTH = MIX_WIDTH // 2
DA_WIDTH = MIX_WIDTH - HG_WIDTH
HG_EXPAND = 128
HG_HEADS = HG_WIDTH // HG_EXPAND
HG_DK = HG_EXPAND
HG_DV = HG_WIDTH // HG_HEADS
HG_CHUNK = 32
DA_STD_HEAD = 128
DA_HEADS = DA_WIDTH // DA_STD_HEAD // 2
DA_HEAD_DIM = DA_WIDTH // DA_HEADS // 2
DA_BLOCK = 128
ROPE_THETA = 10000.0
D_FF = ((8 * D_MODEL // 3 + 255) // 256) * 256
DEEPNORM_ALPHA = (2.0 * DEPTH) ** 0.25
DEEPNORM_BETA = (8.0 * DEPTH) ** -0.25
LN_EPS = 1e-5
RMS_EPS = 1e-6
IN_COLS = 4 * HG_WIDTH + 3 * DA_WIDTH

kernel_name = "hymba_hgrn2_diffattn_deepnorm_adaln"


def layer_norm_plain(x):
    xf = x.astype(jnp.float32)
    mu = jnp.mean(xf, -1, keepdims=True)
    var = jnp.mean(jnp.square(xf - mu), -1, keepdims=True)
    return ((xf - mu) * lax.rsqrt(var + LN_EPS)).astype(x.dtype)


def layer_norm_affine(x, g, b):
    xf = x.astype(jnp.float32)
    mu = jnp.mean(xf, -1, keepdims=True)
    var = jnp.mean(jnp.square(xf - mu), -1, keepdims=True)
    y = (xf - mu) * lax.rsqrt(var + LN_EPS) * g.astype(jnp.float32) + b.astype(jnp.float32)
    return y.astype(x.dtype)


def rms_norm(x, w):
    xf = x.astype(jnp.float32)
    return xf * lax.rsqrt(jnp.mean(xf * xf, -1, keepdims=True) + RMS_EPS) * w.astype(jnp.float32)


def rope_tables(positions, dim):
    inv = 1.0 / (ROPE_THETA ** (jnp.arange(0, dim, 2, dtype=jnp.float32) / dim))
    ang = positions.astype(jnp.float32)[..., None] * inv
    return jnp.cos(ang), jnp.sin(ang)


def apply_rope(x, cos, sin):
    x1, x2 = jnp.split(x.astype(jnp.float32), 2, axis=-1)
    c = cos[:, :, None, :]
    s = sin[:, :, None, :]
    return jnp.concatenate([x1 * c - x2 * s, x2 * c + x1 * s], axis=-1)


def hgrn2_mixer(q, f_logit, i, g, lb, norm_w):
    B, S, _ = q.shape
    C = HG_CHUNK
    N = S // C
    lbf = lb.astype(jnp.float32)
    fl = f_logit.astype(jnp.float32)
    f = lbf + (1.0 - lbf) * jax.nn.sigmoid(fl)
    log_f = jnp.log(f)
    k = (1.0 - lbf) * jax.nn.sigmoid(-fl)

    def to_chunks(t, d):
        return t.reshape(B, N, C, HG_HEADS, d).transpose(0, 3, 1, 2, 4)

    qc = to_chunks(jax.nn.silu(q.astype(jnp.float32)) * (HG_DK ** -0.5), HG_DK)
    kc = to_chunks(k, HG_DK)
    vc = to_chunks(i.astype(jnp.float32), HG_DV)
    G = jnp.cumsum(to_chunks(log_f, HG_DK), axis=3)
    G_ref = G[:, :, :, C // 2 - 1:C // 2, :]
    G_last = G[:, :, :, C - 1:C, :]

    A = jnp.einsum('bhncd,bhnjd->bhncj', qc * jnp.exp(G - G_ref), kc * jnp.exp(G_ref - G))
    causal = jnp.tril(jnp.ones((C, C), dtype=bool))
    A = jnp.where(causal, A, 0.0)
    o_intra = jnp.einsum('bhncj,bhnjv->bhncv', A, vc)

    q_dec = jnp.moveaxis(qc * jnp.exp(G), 2, 0)
    k_dec = jnp.moveaxis(kc * jnp.exp(G_last - G), 2, 0)
    v_ch = jnp.moveaxis(vc, 2, 0)
    d_last = jnp.moveaxis(jnp.exp(G_last[:, :, :, 0, :]), 2, 0)

    def step(state, xs):
        qd, kd, v, dl = xs
        o = jnp.einsum('bhcd,bhdv->bhcv', qd, state)
        state = dl[..., None] * state + jnp.einsum('bhcd,bhcv->bhdv', kd, v)
        return state, o

    s0 = jnp.zeros((B, HG_HEADS, HG_DK, HG_DV), jnp.float32)
    _, o_inter = lax.scan(step, s0, (q_dec, k_dec, v_ch, d_last))
    o = o_intra + jnp.moveaxis(o_inter, 0, 2)
    o = o.transpose(0, 2, 3, 1, 4).reshape(B, S, HG_HEADS, HG_DV)
    o = rms_norm(o, norm_w) * jax.nn.sigmoid(g.astype(jnp.float32)).reshape(B, S, HG_HEADS, HG_DV)
    return o.reshape(B, S, HG_WIDTH)


def diff_attention(q, k, v, cos, sin, lam, subln_w, lambda_init):
    B, S, _ = q.shape
    nb = S // DA_BLOCK
    qh = apply_rope(q.reshape(B, S, 2 * DA_HEADS, DA_HEAD_DIM), cos, sin) * (DA_HEAD_DIM ** -0.5)
    kh = apply_rope(k.reshape(B, S, 2 * DA_HEADS, DA_HEAD_DIM), cos, sin)
    vh = v.astype(jnp.float32).reshape(B, S, DA_HEADS, 2 * DA_HEAD_DIM)
    qb = qh.reshape(B, nb, DA_BLOCK, 2 * DA_HEADS, DA_HEAD_DIM).transpose(1, 0, 3, 2, 4)
    kpos = jnp.arange(S)
    neg = jnp.finfo(jnp.float32).min

    def block(args):
        qi, idx = args
        s = jnp.einsum('bhqd,bkhd->bhqk', qi, kh)
        qpos = idx * DA_BLOCK + jnp.arange(DA_BLOCK)
        s = jnp.where(kpos[None, :] <= qpos[:, None], s, neg)
        p = jax.nn.softmax(s, axis=-1).reshape(B, DA_HEADS, 2, DA_BLOCK, S)
        a = p[:, :, 0] - lam * p[:, :, 1]
        return jnp.einsum('bhqk,bkhv->bhqv', a, vh)

    o = lax.map(block, (qb, jnp.arange(nb)))
    o = o.transpose(1, 0, 3, 2, 4).reshape(B, S, DA_HEADS, 2 * DA_HEAD_DIM)
    o = rms_norm(o, subln_w) * (1.0 - lambda_init)
    return o.reshape(B, S, DA_WIDTH)


def setup_inputs(seed: int = 0) -> dict:
    key = jax.random.key(seed)
    ks = jax.random.split(key, 24)
    nrm = jax.random.normal
    L = DEPTH
    x = nrm(ks[0], (BATCH, SEQ, D_MODEL), jnp.float32)
    c = nrm(ks[1], (BATCH, D_MODEL), jnp.float32)
    positions = jnp.broadcast_to(jnp.arange(SEQ, dtype=jnp.int32), (BATCH, SEQ))
    w_ada = nrm(ks[2], (L, D_MODEL, 6 * D_MODEL), jnp.float32) * D_MODEL ** -0.5
    b_ada = nrm(ks[3], (L, 6 * D_MODEL), jnp.float32) * 0.02
    col_scale = jnp.concatenate([
        jnp.ones((2 * HG_WIDTH,), jnp.float32),
        jnp.full((HG_WIDTH,), DEEPNORM_BETA, jnp.float32),
        jnp.ones((HG_WIDTH + 2 * DA_WIDTH,), jnp.float32),
        jnp.full((DA_WIDTH,), DEEPNORM_BETA, jnp.float32)])
    w_in = nrm(ks[4], (L, D_MODEL, IN_COLS), jnp.float32) * D_MODEL ** -0.5 * col_scale
    lb_logits = nrm(ks[5], (L + 1, HG_WIDTH), jnp.float32)
    hg_norm_w = 1.0 + 0.02 * nrm(ks[6], (L, HG_DV), jnp.float32)
    lam_q1 = 0.1 * nrm(ks[7], (L, DA_HEAD_DIM), jnp.float32)
    lam_k1 = 0.1 * nrm(ks[8], (L, DA_HEAD_DIM), jnp.float32)
    lam_q2 = 0.1 * nrm(ks[9], (L, DA_HEAD_DIM), jnp.float32)
    lam_k2 = 0.1 * nrm(ks[10], (L, DA_HEAD_DIM), jnp.float32)
    subln_w = 1.0 + 0.02 * nrm(ks[11], (L, 2 * DA_HEAD_DIM), jnp.float32)
    w_out = nrm(ks[12], (L, MIX_WIDTH, D_MODEL), jnp.float32) * MIX_WIDTH ** -0.5 * DEEPNORM_BETA
    ln1_g = 1.0 + 0.02 * nrm(ks[13], (L, D_MODEL), jnp.float32)
    ln1_b = 0.02 * nrm(ks[14], (L, D_MODEL), jnp.float32)
    w_gate = nrm(ks[15], (L, D_MODEL, D_FF), jnp.float32) * D_MODEL ** -0.5
    w_up = nrm(ks[16], (L, D_MODEL, D_FF), jnp.float32) * D_MODEL ** -0.5
    w_down = nrm(ks[17], (L, D_FF, D_MODEL), jnp.float32) * D_FF ** -0.5 * DEEPNORM_BETA
    ln2_g = 1.0 + 0.02 * nrm(ks[18], (L, D_MODEL), jnp.float32)
    ln2_b = 0.02 * nrm(ks[19], (L, D_MODEL), jnp.float32)
    return {"x": x, "c": c, "positions": positions, "w_ada": w_ada, "b_ada": b_ada,
            "w_in": w_in, "lb_logits": lb_logits, "hg_norm_w": hg_norm_w,
            "lam_q1": lam_q1, "lam_k1": lam_k1, "lam_q2": lam_q2, "lam_k2": lam_k2,
            "subln_w": subln_w, "w_out": w_out, "ln1_g": ln1_g, "ln1_b": ln1_b,
            "w_gate": w_gate, "w_up": w_up, "w_down": w_down, "ln2_g": ln2_g, "ln2_b": ln2_b}


def reference(x, c, positions, w_ada, b_ada, w_in, lb_logits, hg_norm_w, lam_q1, lam_k1,
              lam_q2, lam_k2, subln_w, w_out, ln1_g, ln1_b, w_gate, w_up, w_down, ln2_g, ln2_b):
    cos, sin = rope_tables(positions, DA_HEAD_DIM)
    lb_all = jnp.cumsum(jax.nn.softmax(lb_logits.astype(jnp.float32), axis=0), axis=0)
    cond = jax.nn.silu(c)
    h = x
    split_pts = [HG_WIDTH, 2 * HG_WIDTH, 3 * HG_WIDTH, 4 * HG_WIDTH,
                 4 * HG_WIDTH + DA_WIDTH, 4 * HG_WIDTH + 2 * DA_WIDTH]
    for l in range(DEPTH):
        mod = jnp.einsum('bd,de->be', cond, w_ada[l]) + b_ada[l]
        sh1, sc1, g1, sh2, sc2, g2 = jnp.split(mod[:, None, :], 6, axis=-1)

        u = layer_norm_plain(h) * (1.0 + sc1) + sh1
        proj = jnp.einsum('bsd,de->bse', u, w_in[l])
        hq, hf, hi, hg, dq, dk, dv = jnp.split(proj, split_pts, axis=-1)
        y_hg = hgrn2_mixer(hq, hf, hi, hg, lb_all[l], hg_norm_w[l])
        lambda_init = 0.8 - 0.6 * math.exp(-0.3 * l)
        lam = (jnp.exp(jnp.sum(lam_q1[l].astype(jnp.float32) * lam_k1[l].astype(jnp.float32)))
               - jnp.exp(jnp.sum(lam_q2[l].astype(jnp.float32) * lam_k2[l].astype(jnp.float32)))
               + lambda_init)
        y_da = diff_attention(dq, dk, dv, cos, sin, lam, subln_w[l], lambda_init)
        mix = jnp.concatenate([y_hg, y_da], axis=-1).astype(h.dtype)
        y = jnp.einsum('bsm,md->bsd', mix, w_out[l])
        h = layer_norm_affine(DEEPNORM_ALPHA * h + g1 * y, ln1_g[l], ln1_b[l])

        u = layer_norm_plain(h) * (1.0 + sc2) + sh2
        a = jnp.einsum('bsd,df->bsf', u, w_gate[l])
        b = jnp.einsum('bsd,df->bsf', u, w_up[l])
        y = jnp.einsum('bsf,fd->bsd', jax.nn.silu(a) * b, w_down[l])
        h = layer_norm_affine(DEEPNORM_ALPHA * h + g2 * y, ln2_g[l], ln2_b[l])
    return h
```

```cpp
#include <hip/hip_runtime.h>
#include <stdint.h>
#include <cstdio>

typedef unsigned short bf16_t;
typedef short bf16x8 __attribute__((ext_vector_type(8)));
typedef float f32x4 __attribute__((ext_vector_type(4)));
typedef unsigned u32x4 __attribute__((ext_vector_type(4)));

constexpr int D = 2048, NB = 4, S = 4096, M = NB * S, NIN = 7168, DFF = 5632, NGU = 2 * DFF;
constexpr float LN_EPS = 1e-5f, RMS_EPS = 1e-6f;
constexpr float ALPHA = 1.189207115002721f;
constexpr float LAMBDA_INIT = 0.2f;
constexpr float LOG2E = 1.4426950408889634f;
constexpr float QSCALE = 0.08838834764831845f;

constexpr size_t MiB = 1u << 20;
constexpr size_t OFF_MOD = 64 * 1024, OFF_LB = 320 * 1024, OFF_LAM = 328 * 1024;
constexpr size_t OFF_COS = 1 * MiB, OFF_SIN = 5 * MiB;
constexpr size_t OFF_WIN = 16 * MiB, OFF_WO = 44 * MiB, OFF_WGU = 52 * MiB, OFF_WD = 96 * MiB;
constexpr size_t OFF_U = 120 * MiB, OFF_MIX = 184 * MiB;
constexpr size_t OFF_QH = 248 * MiB, OFF_VH = 280 * MiB, OFF_GH = 312 * MiB, OFF_LOGF = 344 * MiB, OFF_QA = 408 * MiB, OFF_KA = 440 * MiB, OFF_VA = 472 * MiB;
constexpr size_t OFF_T1 = 248 * MiB, OFF_H1 = 376 * MiB, OFF_HFF = 184 * MiB;
constexpr size_t WS_NEED = 504 * MiB;

__device__ __forceinline__ float bf2f(bf16_t v) { return __uint_as_float((unsigned)v << 16); }
__device__ __forceinline__ bf16_t f2bf(float f) { unsigned u = __float_as_uint(f); return (bf16_t)((u + 0x7fffu + ((u >> 16) & 1u)) >> 16); }
__device__ __forceinline__ unsigned pk2(float lo, float hi) { return (unsigned)f2bf(lo) | ((unsigned)f2bf(hi) << 16); }
__device__ __forceinline__ float sigmoidf_(float x) { return 1.f / (1.f + __expf(-x)); }
__device__ __forceinline__ float wave_sum(float v) {
#pragma unroll
    for (int o = 1; o < 64; o <<= 1) v += __shfl_xor(v, o);
    return v;
}

__global__ __launch_bounds__(128) void k_mod(const float* __restrict__ c, const float* __restrict__ w_ada, const float* __restrict__ b_ada, float* __restrict__ mod) {
    __shared__ float cond[NB][D];
    for (int i = threadIdx.x; i < NB * D; i += 128) { const float v = c[i]; cond[i / D][i % D] = v / (1.f + __expf(-v)); }
    __syncthreads();
    const int e = blockIdx.x * 128 + threadIdx.x;
    float a0 = 0, a1 = 0, a2 = 0, a3 = 0;
    for (int d = 0; d < D; ++d) { const float w = w_ada[(size_t)d * (6 * D) + e]; a0 += cond[0][d] * w; a1 += cond[1][d] * w; a2 += cond[2][d] * w; a3 += cond[3][d] * w; }
    const float bb = b_ada[e];
    mod[0 * 6 * D + e] = a0 + bb; mod[1 * 6 * D + e] = a1 + bb; mod[2 * 6 * D + e] = a2 + bb; mod[3 * 6 * D + e] = a3 + bb;
}
__global__ __launch_bounds__(256) void k_small(const int* __restrict__ positions, const float* __restrict__ lb_logits, const float* __restrict__ lq1, const float* __restrict__ lk1,
                                               const float* __restrict__ lq2, const float* __restrict__ lk2, float* __restrict__ cosT, float* __restrict__ sinT, float* __restrict__ lbv, float* __restrict__ lam) {
    const int gid = blockIdx.x * 256 + threadIdx.x;
    if (gid < M * 64) {
        const int row = gid >> 6, i = gid & 63;
        const double inv = exp2(-(double)i * (13.287712379549449 / 64.0));
        const double rev = (double)positions[row] * inv * 0.15915494309189535;
        const float fr = (float)(rev - rint(rev));
        cosT[gid] = __builtin_amdgcn_cosf(fr); sinT[gid] = __builtin_amdgcn_sinf(fr);
    }
    if (gid < 1024) lbv[gid] = 1.f / (1.f + __expf(lb_logits[1024 + gid] - lb_logits[gid]));
    if (gid == 0) { float s1 = 0, s2 = 0; for (int i = 0; i < 128; ++i) { s1 += lq1[i] * lk1[i]; s2 += lq2[i] * lk2[i]; } lam[0] = expf(s1) - expf(s2) + LAMBDA_INIT; }
}
__device__ __forceinline__ int src_col_win(int n) {
    const int pn = n >> 8, t = n & 255, seg = pn >> 2, pt = pn & 3;
    if (seg == 4 || seg == 5) { const int bj = t >> 7, o = t & 127; return seg * 1024 + (2 * pt + (o >> 6)) * 128 + (o & 63) + 64 * bj; }
    return n;
}
template <int MODE>
__global__ __launch_bounds__(256) void k_convert(const float* __restrict__ W, const float* __restrict__ W2, bf16_t* __restrict__ Bt, int K, int Nsrc, int Nphys) {
    __shared__ float tile[32][33];
    const int n0 = blockIdx.x * 32, k0 = blockIdx.y * 32, tx = threadIdx.x & 31, ty = threadIdx.x >> 5;
    for (int r = ty; r < 32; r += 8) {
        const int n = n0 + tx; const float* src = W; int sc = n;
        if (MODE == 1) sc = src_col_win(n);
        if (MODE == 2) { const int pn = n >> 8, t = n & 255; if (t < 128) sc = 128 * pn + t; else { sc = 128 * pn + t - 128; src = W2; } }
        tile[r][tx] = src[(size_t)(k0 + r) * Nsrc + sc];
    }
    __syncthreads();
    for (int r = ty; r < 32; r += 8) Bt[(size_t)(n0 + r) * K + k0 + tx] = f2bf(tile[tx][r]);
}
__global__ __launch_bounds__(256) void k_ln_mod(const float* __restrict__ x, const float* __restrict__ mod, int sh_off, int sc_off, bf16_t* __restrict__ U) {
    const int row = blockIdx.x * 4 + (threadIdx.x >> 6), lane = threadIdx.x & 63, b = row / S;
    const f32x4* xr = (const f32x4*)(x + (size_t)row * D) + lane;
    f32x4 v[8]; float s = 0;
#pragma unroll
    for (int j = 0; j < 8; ++j) { v[j] = xr[64 * j]; s += (v[j][0] + v[j][1]) + (v[j][2] + v[j][3]); }
    const float mean = wave_sum(s) * (1.f / D); float q = 0;
#pragma unroll
    for (int j = 0; j < 8; ++j) { v[j] = v[j] - mean; q += (v[j][0] * v[j][0] + v[j][1] * v[j][1]) + (v[j][2] * v[j][2] + v[j][3] * v[j][3]); }
    const float rstd = rsqrtf(wave_sum(q) * (1.f / D) + LN_EPS);
    const float* mb = mod + (size_t)b * 6 * D;
#pragma unroll
    for (int j = 0; j < 8; ++j) { const int col = 4 * lane + 256 * j; const f32x4 sc = *(const f32x4*)(mb + sc_off + col), sh = *(const f32x4*)(mb + sh_off + col);
        const f32x4 o = v[j] * rstd * (sc + 1.f) + sh;
        uint2 w; w.x = pk2(o[0], o[1]); w.y = pk2(o[2], o[3]); *(uint2*)(U + (size_t)row * D + col) = w; }
}
__global__ __launch_bounds__(256) void k_ln1(const float* __restrict__ T1, const float* __restrict__ g, const float* __restrict__ bt, const float* __restrict__ mod, float* __restrict__ H1, bf16_t* __restrict__ U2) {
    const int row = blockIdx.x * 4 + (threadIdx.x >> 6), lane = threadIdx.x & 63, b = row / S;
    const f32x4* xr = (const f32x4*)(T1 + (size_t)row * D) + lane;
    f32x4 v[8]; float s = 0;
#pragma unroll
    for (int j = 0; j < 8; ++j) { v[j] = xr[64 * j]; s += (v[j][0] + v[j][1]) + (v[j][2] + v[j][3]); }
    float mean = wave_sum(s) * (1.f / D); float q = 0;
#pragma unroll
    for (int j = 0; j < 8; ++j) { v[j] = v[j] - mean; q += (v[j][0] * v[j][0] + v[j][1] * v[j][1]) + (v[j][2] * v[j][2] + v[j][3] * v[j][3]); }
    float rstd = rsqrtf(wave_sum(q) * (1.f / D) + LN_EPS);
    s = 0;
#pragma unroll
    for (int j = 0; j < 8; ++j) { const int col = 4 * lane + 256 * j; v[j] = v[j] * rstd * *(const f32x4*)(g + col) + *(const f32x4*)(bt + col);
        *(f32x4*)(H1 + (size_t)row * D + col) = v[j]; s += (v[j][0] + v[j][1]) + (v[j][2] + v[j][3]); }
    mean = wave_sum(s) * (1.f / D); q = 0;
#pragma unroll
    for (int j = 0; j < 8; ++j) { v[j] = v[j] - mean; q += (v[j][0] * v[j][0] + v[j][1] * v[j][1]) + (v[j][2] * v[j][2] + v[j][3] * v[j][3]); }
    rstd = rsqrtf(wave_sum(q) * (1.f / D) + LN_EPS);
    const float* mb = mod + (size_t)b * 6 * D;
#pragma unroll
    for (int j = 0; j < 8; ++j) { const int col = 4 * lane + 256 * j; const f32x4 sc = *(const f32x4*)(mb + 4 * D + col), sh = *(const f32x4*)(mb + 3 * D + col);
        const f32x4 o = v[j] * rstd * (sc + 1.f) + sh;
        uint2 w; w.x = pk2(o[0], o[1]); w.y = pk2(o[2], o[3]); *(uint2*)(U2 + (size_t)row * D + col) = w; }
}
__global__ __launch_bounds__(256) void k_ln_final(float* __restrict__ out, const float* __restrict__ g, const float* __restrict__ bt) {
    const int row = blockIdx.x * 4 + (threadIdx.x >> 6), lane = threadIdx.x & 63;
    f32x4* xr = (f32x4*)(out + (size_t)row * D) + lane;
    f32x4 v[8]; float s = 0;
#pragma unroll
    for (int j = 0; j < 8; ++j) { v[j] = xr[64 * j]; s += (v[j][0] + v[j][1]) + (v[j][2] + v[j][3]); }
    const float mean = wave_sum(s) * (1.f / D); float q = 0;
#pragma unroll
    for (int j = 0; j < 8; ++j) { v[j] = v[j] - mean; q += (v[j][0] * v[j][0] + v[j][1] * v[j][1]) + (v[j][2] * v[j][2] + v[j][3] * v[j][3]); }
    const float rstd = rsqrtf(wave_sum(q) * (1.f / D) + LN_EPS);
#pragma unroll
    for (int j = 0; j < 8; ++j) { const int col = 4 * lane + 256 * j; xr[64 * j] = v[j] * rstd * *(const f32x4*)(g + col) + *(const f32x4*)(bt + col); }
}

struct Epi1 {
    bf16_t *Qh, *Vh, *Gh, *Qa, *Ka, *Va; float* Logf; const float *lbv, *cosT, *sinT;
    __device__ __forceinline__ void operator()(int row, int pn, int c, const float (&lo)[8], const float (&hi)[8]) const {
        const int seg = pn >> 2, pt = pn & 3;
        if (seg == 4 || seg == 5) {
            const int head = 2 * pt + (c >> 6), d0 = c & 63; const float sc = (seg == 4) ? QSCALE * LOG2E : 1.f;
            float o1[8], o2[8];
#pragma unroll
            for (int j = 0; j < 8; ++j) { const float cs = cosT[(size_t)row * 64 + d0 + j], sn = sinT[(size_t)row * 64 + d0 + j];
                o1[j] = (lo[j] * cs - hi[j] * sn) * sc; o2[j] = (hi[j] * cs + lo[j] * sn) * sc; }
            bf16_t* dst = (seg == 4 ? Qa : Ka) + (size_t)row * 1024 + head * 128 + d0;
            u32x4 w1 = {pk2(o1[0], o1[1]), pk2(o1[2], o1[3]), pk2(o1[4], o1[5]), pk2(o1[6], o1[7])}, w2 = {pk2(o2[0], o2[1]), pk2(o2[2], o2[3]), pk2(o2[4], o2[5]), pk2(o2[6], o2[7])};
            *(u32x4*)dst = w1; *(u32x4*)(dst + 64) = w2;
            return;
        }
#pragma unroll
        for (int h = 0; h < 2; ++h) {
            const int col = 256 * pt + 128 * h + c; float v[8];
#pragma unroll
            for (int j = 0; j < 8; ++j) v[j] = h ? hi[j] : lo[j];
            if (seg == 1) {
                float* dst = Logf + (size_t)row * 1024 + col;
#pragma unroll
                for (int j = 0; j < 8; ++j) { const float lb = lbv[col + j]; const float f = lb + (1.f - lb) * sigmoidf_(v[j]); dst[j] = __log2f(f); }
            } else {
                if (seg == 0) {
#pragma unroll
                    for (int j = 0; j < 8; ++j) v[j] = v[j] * sigmoidf_(v[j]) * QSCALE;
                } else if (seg == 3) {
#pragma unroll
                    for (int j = 0; j < 8; ++j) v[j] = sigmoidf_(v[j]);
                }
                bf16_t* dst = (seg == 0 ? Qh : seg == 2 ? Vh : seg == 3 ? Gh : Va) + (size_t)row * 1024 + col;
                u32x4 w = {pk2(v[0], v[1]), pk2(v[2], v[3]), pk2(v[4], v[5]), pk2(v[6], v[7])};
                *(u32x4*)dst = w;
            }
        }
    }
};
struct EpiRes {
    const float* res; const float* mod; int g_off; float* out;
    __device__ __forceinline__ void operator()(int row, int pn, int c, const float (&lo)[8], const float (&hi)[8]) const {
        const int b = row / S;
#pragma unroll
        for (int h = 0; h < 2; ++h) { const int col = 256 * pn + 128 * h + c;
#pragma unroll
            for (int j = 0; j < 8; ++j) { const float v = h ? hi[j] : lo[j]; out[(size_t)row * D + col + j] = ALPHA * res[(size_t)row * D + col + j] + mod[(size_t)b * 6 * D + g_off + col + j] * v; } }
    }
};
struct EpiSwiglu {
    bf16_t* Hff;
    __device__ __forceinline__ void operator()(int row, int pn, int c, const float (&lo)[8], const float (&hi)[8]) const {
        float v[8];
#pragma unroll
        for (int j = 0; j < 8; ++j) v[j] = lo[j] * sigmoidf_(lo[j]) * hi[j];
        u32x4 w = {pk2(v[0], v[1]), pk2(v[2], v[3]), pk2(v[4], v[5]), pk2(v[6], v[7])};
        *(u32x4*)(Hff + (size_t)row * DFF + 128 * pn + c) = w;
    }
};

template <class Epi>
__global__ __launch_bounds__(256) void gemm_simple(const bf16_t* __restrict__ A, const bf16_t* __restrict__ Bt, int K, int nN, Epi epi) {
    __shared__ float Cs[32][260];
    const int pn = blockIdx.x % nN, rb = blockIdx.x / nN;
    const int wave = threadIdx.x >> 6, lane = threadIdx.x & 63, fr = lane & 15, fq = lane >> 4;
    f32x4 acc[2][4];
#pragma unroll
    for (int i = 0; i < 2; ++i)
#pragma unroll
        for (int j = 0; j < 4; ++j) acc[i][j] = (f32x4){0.f, 0.f, 0.f, 0.f};
    const bf16_t* Ap = A + (size_t)(rb * 32 + fr) * K + fq * 8;
    const bf16_t* Bp = Bt + (size_t)(pn * 256 + wave * 64 + fr) * K + fq * 8;
    for (int k0 = 0; k0 < K; k0 += 32) {
        bf16x8 a[2], b[4];
#pragma unroll
        for (int i = 0; i < 2; ++i) a[i] = *(const bf16x8*)(Ap + (size_t)i * 16 * K + k0);
#pragma unroll
        for (int j = 0; j < 4; ++j) b[j] = *(const bf16x8*)(Bp + (size_t)j * 16 * K + k0);
#pragma unroll
        for (int i = 0; i < 2; ++i)
#pragma unroll
            for (int j = 0; j < 4; ++j) acc[i][j] = __builtin_amdgcn_mfma_f32_16x16x32_bf16(a[i], b[j], acc[i][j], 0, 0, 0);
    }
#pragma unroll
    for (int i = 0; i < 2; ++i)
#pragma unroll
        for (int j = 0; j < 4; ++j)
#pragma unroll
            for (int r = 0; r < 4; ++r) Cs[i * 16 + fq * 4 + r][wave * 64 + j * 16 + fr] = acc[i][j][r];
    __syncthreads();
    for (int it = threadIdx.x; it < 32 * 16; it += 256) {
        const int r = it >> 4, c = (it & 15) * 8; float lo[8], hi[8];
#pragma unroll
        for (int j = 0; j < 8; ++j) { lo[j] = Cs[r][c + j]; hi[j] = Cs[r][128 + c + j]; }
        epi(rb * 32 + r, pn, c, lo, hi);
    }
}

__global__ __launch_bounds__(128) void hgrn_simple(const bf16_t* __restrict__ Qh, const float* __restrict__ Logf, const bf16_t* __restrict__ Vh, const bf16_t* __restrict__ Gh,
                                                   const float* __restrict__ nw, bf16_t* __restrict__ MIX) {
    __shared__ float sf[128], sk[128], sq[128], red[2];
    const int b = blockIdx.x >> 3, h = blockIdx.x & 7, tid = threadIdx.x;
    float St[128];
#pragma unroll
    for (int d = 0; d < 128; ++d) St[d] = 0.f;
    const float w = nw[tid];
    for (int t = 0; t < S; ++t) {
        const size_t off = (size_t)(b * S + t) * 1024 + h * 128 + tid;
        const float f = exp2f(Logf[off]);
        sf[tid] = f; sk[tid] = 1.f - f; sq[tid] = bf2f(Qh[off]);
        const float vv = bf2f(Vh[off]), gg = bf2f(Gh[off]);
        __syncthreads();
        float o = 0.f;
#pragma unroll
        for (int d = 0; d < 128; ++d) { St[d] = sf[d] * St[d] + sk[d] * vv; o += St[d] * sq[d]; }
        const float ss = wave_sum(o * o);
        if ((tid & 63) == 0) red[tid >> 6] = ss;
        __syncthreads();
        const float tot = red[0] + red[1];
        MIX[(size_t)(b * S + t) * D + h * 128 + tid] = f2bf(o * rsqrtf(tot * (1.f / 128.f) + RMS_EPS) * w * gg);
    }
}

__global__ __launch_bounds__(256) void attn_simple(const bf16_t* __restrict__ Qa, const bf16_t* __restrict__ Ka, const bf16_t* __restrict__ Va, const float* __restrict__ lamp,
                                                   const float* __restrict__ subw, bf16_t* __restrict__ MIX) {
    __shared__ float qs[16][128];
    __shared__ bf16_t ks[64][130];
    __shared__ bf16_t vs[64][256];
    __shared__ float ps[16][64];
    const int qb = blockIdx.x & 255, h = (blockIdx.x >> 8) & 3, b = blockIdx.x >> 10;
    const int tid = threadIdx.x, r = tid >> 4, j = tid & 15;
    const int q0 = qb * 16, qpos = q0 + r;
    const float lam = lamp[0];
    float res[16];
#pragma unroll
    for (int c = 0; c < 16; ++c) res[c] = 0.f;
    for (int sub = 0; sub < 2; ++sub) {
        const int hh = 2 * h + sub;
        __syncthreads();
        for (int i = tid; i < 16 * 128; i += 256) qs[i >> 7][i & 127] = bf2f(Qa[(size_t)(b * S + q0 + (i >> 7)) * 1024 + hh * 128 + (i & 127)]);
        float m = -1e30f, l = 0.f, o[16];
#pragma unroll
        for (int c = 0; c < 16; ++c) o[c] = 0.f;
        const int nt = (q0 + 15) / 64 + 1;
        for (int t = 0; t < nt; ++t) {
            __syncthreads();
            for (int i = tid; i < 64 * 128; i += 256) ks[i >> 7][i & 127] = Ka[(size_t)(b * S + t * 64 + (i >> 7)) * 1024 + hh * 128 + (i & 127)];
            for (int i = tid; i < 64 * 256; i += 256) vs[i >> 8][i & 255] = Va[(size_t)(b * S + t * 64 + (i >> 8)) * 1024 + h * 256 + (i & 255)];
            __syncthreads();
            float sc[4]; float mx = -1e30f;
#pragma unroll
            for (int i = 0; i < 4; ++i) { const int kk = j + 16 * i; float a = 0.f;
                for (int d = 0; d < 128; ++d) a += qs[r][d] * bf2f(ks[kk][d]);
                sc[i] = (t * 64 + kk <= qpos) ? a : -INFINITY; mx = fmaxf(mx, sc[i]); }
#pragma unroll
            for (int o_ = 1; o_ < 16; o_ <<= 1) mx = fmaxf(mx, __shfl_xor(mx, o_));
            const float mn = fmaxf(m, mx), alpha = exp2f(m - mn); m = mn;
            float psum = 0.f;
#pragma unroll
            for (int i = 0; i < 4; ++i) { const float p = exp2f(sc[i] - mn); ps[r][j + 16 * i] = p; psum += p; }
#pragma unroll
            for (int o_ = 1; o_ < 16; o_ <<= 1) psum += __shfl_xor(psum, o_);
            l = l * alpha + psum;
            __syncthreads();
#pragma unroll
            for (int c = 0; c < 16; ++c) o[c] *= alpha;
            for (int kk = 0; kk < 64; ++kk) { const float p = ps[r][kk];
#pragma unroll
                for (int c = 0; c < 16; ++c) o[c] += p * bf2f(vs[kk][16 * j + c]); }
        }
        const float il = 1.f / l, sg = sub ? -lam : 1.f;
#pragma unroll
        for (int c = 0; c < 16; ++c) res[c] += sg * o[c] * il;
    }
    float ss = 0.f;
#pragma unroll
    for (int c = 0; c < 16; ++c) ss += res[c] * res[c];
#pragma unroll
    for (int o_ = 1; o_ < 16; o_ <<= 1) ss += __shfl_xor(ss, o_);
    const float rs = rsqrtf(ss * (1.f / 256.f) + RMS_EPS) * (1.f - LAMBDA_INIT);
#pragma unroll
    for (int c = 0; c < 16; ++c) MIX[(size_t)(b * S + qpos) * D + 1024 + h * 256 + 16 * j + c] = f2bf(res[c] * rs * subw[16 * j + c]);
}

extern "C" void kernel_launch(void* const* d_in, const int* in_sizes, int n_in, void* d_out, int out_size, void* d_ws, size_t ws_size, hipStream_t stream) {
    if (n_in != 21 || in_sizes[0] != M * D || out_size != M * D || ws_size < WS_NEED) { fprintf(stderr, "kernel_launch: unexpected shapes (n_in %d, in0 %d, out %d, ws %zu)\n", n_in, n_in > 0 ? in_sizes[0] : -1, out_size, ws_size); return; }
    const float* x = (const float*)d_in[0]; const float* c = (const float*)d_in[1]; const int* positions = (const int*)d_in[2];
    const float* w_ada = (const float*)d_in[3]; const float* b_ada = (const float*)d_in[4]; const float* w_in = (const float*)d_in[5];
    const float* lb_logits = (const float*)d_in[6]; const float* hg_norm_w = (const float*)d_in[7];
    const float* lq1 = (const float*)d_in[8]; const float* lk1 = (const float*)d_in[9]; const float* lq2 = (const float*)d_in[10]; const float* lk2 = (const float*)d_in[11];
    const float* subln_w = (const float*)d_in[12]; const float* w_out = (const float*)d_in[13]; const float* ln1_g = (const float*)d_in[14]; const float* ln1_b = (const float*)d_in[15];
    const float* w_gate = (const float*)d_in[16]; const float* w_up = (const float*)d_in[17]; const float* w_down = (const float*)d_in[18];
    const float* ln2_g = (const float*)d_in[19]; const float* ln2_b = (const float*)d_in[20];
    float* out = (float*)d_out; char* ws = (char*)d_ws;
    float* mod = (float*)(ws + OFF_MOD); float* lbv = (float*)(ws + OFF_LB); float* lam = (float*)(ws + OFF_LAM);
    float* cosT = (float*)(ws + OFF_COS); float* sinT = (float*)(ws + OFF_SIN);
    bf16_t* WinT = (bf16_t*)(ws + OFF_WIN); bf16_t* WoT = (bf16_t*)(ws + OFF_WO); bf16_t* WguT = (bf16_t*)(ws + OFF_WGU); bf16_t* WdT = (bf16_t*)(ws + OFF_WD);
    bf16_t* U = (bf16_t*)(ws + OFF_U); bf16_t* MIX = (bf16_t*)(ws + OFF_MIX);
    bf16_t* Qh = (bf16_t*)(ws + OFF_QH); bf16_t* Vh = (bf16_t*)(ws + OFF_VH); bf16_t* Gh = (bf16_t*)(ws + OFF_GH); float* Logf = (float*)(ws + OFF_LOGF);
    bf16_t* Qa = (bf16_t*)(ws + OFF_QA); bf16_t* Ka = (bf16_t*)(ws + OFF_KA); bf16_t* Va = (bf16_t*)(ws + OFF_VA);
    float* T1 = (float*)(ws + OFF_T1); float* H1 = (float*)(ws + OFF_H1); bf16_t* Hff = (bf16_t*)(ws + OFF_HFF);

    k_mod<<<6 * D / 128, 128, 0, stream>>>(c, w_ada, b_ada, mod);
    k_small<<<M * 64 / 256, 256, 0, stream>>>(positions, lb_logits, lq1, lk1, lq2, lk2, cosT, sinT, lbv, lam);
    k_convert<1><<<dim3(NIN / 32, D / 32), 256, 0, stream>>>(w_in, nullptr, WinT, D, NIN, NIN);
    k_convert<0><<<dim3(D / 32, D / 32), 256, 0, stream>>>(w_out, nullptr, WoT, D, D, D);
    k_convert<2><<<dim3(NGU / 32, D / 32), 256, 0, stream>>>(w_gate, w_up, WguT, D, DFF, NGU);
    k_convert<0><<<dim3(D / 32, DFF / 32), 256, 0, stream>>>(w_down, nullptr, WdT, DFF, D, D);
    k_ln_mod<<<M / 4, 256, 0, stream>>>(x, mod, 0, D, U);
    gemm_simple<Epi1><<<(M / 32) * (NIN / 256), 256, 0, stream>>>(U, WinT, D, NIN / 256, Epi1{Qh, Vh, Gh, Qa, Ka, Va, Logf, lbv, cosT, sinT});
    hgrn_simple<<<NB * 8, 128, 0, stream>>>(Qh, Logf, Vh, Gh, hg_norm_w, MIX);
    attn_simple<<<NB * 4 * 256, 256, 0, stream>>>(Qa, Ka, Va, lam, subln_w, MIX);
    gemm_simple<EpiRes><<<(M / 32) * (D / 256), 256, 0, stream>>>(MIX, WoT, D, D / 256, EpiRes{x, mod, 2 * D, T1});
    k_ln1<<<M / 4, 256, 0, stream>>>(T1, ln1_g, ln1_b, mod, H1, U);
    gemm_simple<EpiSwiglu><<<(M / 32) * (NGU / 256), 256, 0, stream>>>(U, WguT, D, NGU / 256, EpiSwiglu{Hff});
    gemm_simple<EpiRes><<<(M / 32) * (D / 256), 256, 0, stream>>>(Hff, WdT, DFF, D / 256, EpiRes{H1, mod, 5 * D, out});
    k_ln_final<<<M / 4, 256, 0, stream>>>(out, ln2_g, ln2_b);
}
```

```cpp
#include <hip/hip_runtime.h>
#include <hip/hip_cooperative_groups.h>
#include <stdint.h>
#include <cstdio>
namespace cg = cooperative_groups;
namespace pg8 {
#define PG8_LAS __attribute__((address_space(3)))
typedef unsigned short bf16_t;
typedef short bf16x8 __attribute__((ext_vector_type(8)));
typedef float f32x4 __attribute__((ext_vector_type(4)));
typedef unsigned u32x4 __attribute__((ext_vector_type(4)));
constexpr int BM = 256, BK = 64, HALF = 128, HTB = HALF * BK * 2  , STAGE_BYTES = 8 * HTB, NXCD = 8, WGM = 8;

__host__ __device__ __forceinline__ int lds_byte(int r, int c) { const int st = (r >> 4) * 2 + (c >> 5), rr = r & 15, cc = c & 31, ob = rr * 64 + cc * 2; return st * 1024 + (ob ^ (((ob >> 9) & 1) << 5)); }
__host__ __device__ __forceinline__ void stage_rc(int b, int& R, int& C) { const int st = b / 1024, sb = b % 1024, swz = sb ^ (((sb >> 9) & 1) << 5); R = (st >> 1) * 16 + swz / 64; C = (st & 1) * 32 + (swz % 64) / 2; }
__host__ __device__ __forceinline__ int perm32(int rho) { const int n = rho >> 4, i = rho & 15; return 8 * (i >> 2) + 4 * n + (i & 3); }

struct Unit { int pm, pn; };
struct Gemm { const bf16_t* A; const bf16_t* Bt; int M, N, K; };

struct StaticOrder {
    int nM, nN, nwg, G, c;
    __host__ __device__ void init(int M, int N, int G_, int c_) { nM = M / BM; nN = N / BM; nwg = nM * nN; G = G_; c = c_; }
    __host__ __device__ bool next(int i, Unit& u) const {
        const long L = (long)i * G + c; if (L >= nwg) return false;
        int wgid = (int)L; { const int q = nwg / NXCD, r = nwg % NXCD, xcd = wgid % NXCD, off = wgid / NXCD; wgid = (xcd < r ? xcd * (q + 1) : r * (q + 1) + (xcd - r) * q) + off; }
        const int nig = WGM * nN, gid = wgid / nig, fm = gid * WGM, gsz = (nM - fm) < WGM ? (nM - fm) : WGM;
        u.pm = fm + ((wgid % nig) % gsz); u.pn = (wgid % nig) / gsz; return true;
    }
    __device__ __forceinline__ void a_ready(const Unit&) const {}
    __device__ __forceinline__ void done(const Unit&) const {}
};
template <class Epi, class Sched, bool ALIGN_EPI = false, bool SP2 = false>
__device__ __forceinline__ void gemm_phase(PG8_LAS unsigned char* lds, const Gemm g, const Sched& S, const Epi& E) {
    const int tid = threadIdx.x, wid = __builtin_amdgcn_readfirstlane(tid >> 6), lane = tid & 63, wr = wid >> 2, wc = wid & 3, fr = lane & 15, fq = lane >> 4;
    const int K = g.K, nt = K / BK;
    unsigned voffA[2], voffB[2];
#pragma unroll
    for (int i = 0; i < 2; ++i) { int R, C; stage_rc(tid * 16 + i * 8192, R, C); const int Rb = Epi::PERM ? ((R & ~31) + perm32(R & 31)) : R;
        voffA[i] = (unsigned)(R * K + C) * 2u; voffB[i] = (unsigned)(Rb * K + C) * 2u; }
    const size_t kstep = (size_t)(BK * 2);
    const size_t hstep = (size_t)HALF * K * 2;
    const size_t tstep = 2 * hstep;
    const unsigned ldsw = (unsigned)wid * 1024u;
    const int aoff = lds_byte(wr * 64 + fr, fq * 8), boff = lds_byte(wc * 32 + fr, fq * 8);
#define PG8_SA(b, h) (((b) * 2 + (h)) * HTB)
#define PG8_SB(b, h) ((4 + (b) * 2 + (h)) * HTB)
#define PG8_STAGE(bufoff, gbase, voff) do { _Pragma("unroll") for (int _i = 0; _i < 2; ++_i) \
        __builtin_amdgcn_global_load_lds((const unsigned*)((const char*)(gbase) + (voff)[_i]), (PG8_LAS unsigned*)(lds + (bufoff) + ldsw + _i * 8192), 16, 0, 0); } while (0)
#define PG8_LDA(dst, b, h) do { _Pragma("unroll") for (int m = 0; m < 4; ++m) _Pragma("unroll") for (int k = 0; k < 2; ++k) dst[m][k] = *(const PG8_LAS bf16x8*)(lds + PG8_SA(b, h) + aoff + m * 2048 + k * 1024); } while (0)
#define PG8_LDB(dst, b, h) do { _Pragma("unroll") for (int n = 0; n < 2; ++n) _Pragma("unroll") for (int k = 0; k < 2; ++k) dst[n][k] = *(const PG8_LAS bf16x8*)(lds + PG8_SB(b, h) + boff + n * 2048 + k * 1024); } while (0)
#define PG8_MMA(ai, bj, At, Bt) do { __builtin_amdgcn_s_setprio(1); _Pragma("unroll") for (int m = 0; m < 4; ++m) _Pragma("unroll") for (int n = 0; n < 2; ++n) _Pragma("unroll") for (int k = 0; k < 2; ++k) \
        acc[ai][bj][m][n] = __builtin_amdgcn_mfma_f32_16x16x32_bf16(Bt[n][k], At[m][k], acc[ai][bj][m][n], 0, 0, 0); __builtin_amdgcn_s_setprio(0); } while (0)
#define PG8_WAIT_V(n) asm volatile("s_waitcnt vmcnt(" #n ")" ::: "memory")
#define PG8_WAIT_L(n) asm volatile("s_waitcnt lgkmcnt(" #n ")" ::: "memory")
#define PG8_BAR __builtin_amdgcn_s_barrier()
#define PG8_SCHED __builtin_amdgcn_sched_barrier(0)
    Unit cur, nxt; int ui = 0;
    if (!S.next(0, cur)) return;
    f32x4 acc[2][2][4][2];
#pragma unroll
    for (int a = 0; a < 2; ++a)
#pragma unroll
        for (int b = 0; b < 2; ++b)
#pragma unroll
            for (int m = 0; m < 4; ++m)
#pragma unroll
                for (int n = 0; n < 2; ++n) acc[a][b][m][n] = (f32x4){0.f, 0.f, 0.f, 0.f};
    bf16x8 At[4][2], B0[2][2], B1[2][2];
    const char* cA = (const char*)g.A + (size_t)cur.pm * tstep; const char* cB = (const char*)g.Bt + (size_t)cur.pn * tstep;
    S.a_ready(cur);
    if constexpr (SP2) {
        PG8_STAGE(PG8_SB(0, 0), cB, voffB); PG8_STAGE(PG8_SB(0, 1), cB + hstep, voffB); PG8_STAGE(PG8_SA(0, 0), cA, voffA); PG8_STAGE(PG8_SA(0, 1), cA + hstep, voffA);
        if (wr == 1) PG8_BAR;
        PG8_WAIT_V(2); PG8_BAR;
        PG8_STAGE(PG8_SB(1, 0), cB + kstep, voffB); PG8_STAGE(PG8_SA(1, 0), cA + kstep, voffA); PG8_STAGE(PG8_SB(1, 1), cB + hstep + kstep, voffB);
        PG8_WAIT_V(6); PG8_BAR;
    } else {
        PG8_STAGE(PG8_SB(0, 0), cB, voffB); PG8_STAGE(PG8_SA(0, 0), cA, voffA); PG8_STAGE(PG8_SB(0, 1), cB + hstep, voffB); PG8_STAGE(PG8_SA(0, 1), cA + hstep, voffA);
        if (wr == 1) PG8_BAR;
        PG8_WAIT_V(4); PG8_BAR;
        PG8_STAGE(PG8_SB(1, 0), cB + kstep, voffB); PG8_STAGE(PG8_SA(1, 0), cA + kstep, voffA); PG8_STAGE(PG8_SB(1, 1), cB + hstep + kstep, voffB);
        PG8_WAIT_V(6); PG8_BAR;
    }
    for (;;) {
        const bool has_next = S.next(ui + 1, nxt);
        const char* nA = has_next ? (const char*)g.A + (size_t)nxt.pm * tstep : cA; const char* nB = has_next ? (const char*)g.Bt + (size_t)nxt.pn * tstep : cB;
        for (int t = 0; t < nt; t += 2) {
            const bool last = (t == nt - 2);
            const char* a1 = cA + (size_t)(t + 1) * kstep;
            const char* a2 = last ? nA : cA + (size_t)(t + 2) * kstep; const char* b2 = last ? nB : cB + (size_t)(t + 2) * kstep;
            const char* a3 = a2 + kstep; const char* b3 = b2 + kstep;
            if (last && has_next) S.a_ready(nxt);
            if constexpr (SP2) {
            PG8_LDB(B0, 0, 0); PG8_LDB(B1, 0, 1); PG8_SCHED; PG8_LDA(At, 0, 0); PG8_STAGE(PG8_SA(1, 1), a1 + hstep, voffA);
            PG8_WAIT_V(8); PG8_WAIT_L(0); PG8_BAR; PG8_MMA(0, 0, At, B0); PG8_MMA(0, 1, At, B1); PG8_BAR; PG8_SCHED;
            PG8_LDA(At, 0, 1); PG8_STAGE(PG8_SB(0, 0), b2, voffB); PG8_STAGE(PG8_SB(0, 1), b2 + hstep, voffB); PG8_STAGE(PG8_SA(0, 0), a2, voffA);
            PG8_WAIT_V(8); PG8_WAIT_L(0); PG8_BAR; PG8_MMA(1, 0, At, B0); PG8_MMA(1, 1, At, B1); PG8_BAR; PG8_SCHED;
            PG8_LDB(B0, 1, 0); PG8_LDB(B1, 1, 1); PG8_SCHED; PG8_LDA(At, 1, 0); PG8_STAGE(PG8_SA(0, 1), a2 + hstep, voffA);
            PG8_WAIT_V(8); PG8_WAIT_L(0); PG8_BAR; PG8_MMA(0, 0, At, B0); PG8_MMA(0, 1, At, B1); PG8_BAR; PG8_SCHED;
            PG8_LDA(At, 1, 1); PG8_STAGE(PG8_SB(1, 0), b3, voffB); PG8_STAGE(PG8_SB(1, 1), b3 + hstep, voffB); PG8_STAGE(PG8_SA(1, 0), a3, voffA);
            PG8_WAIT_V(8); PG8_WAIT_L(0); PG8_BAR; PG8_MMA(1, 0, At, B0); PG8_MMA(1, 1, At, B1); PG8_BAR; PG8_SCHED;
            } else {
            PG8_LDB(B0, 0, 0); PG8_SCHED; PG8_LDA(At, 0, 0); PG8_STAGE(PG8_SA(1, 1), a1 + hstep, voffA);
            PG8_WAIT_L(8); PG8_BAR; PG8_WAIT_L(0); PG8_MMA(0, 0, At, B0); PG8_BAR; PG8_SCHED;
            PG8_LDB(B1, 0, 1); PG8_STAGE(PG8_SB(0, 0), b2, voffB);
            PG8_BAR; PG8_WAIT_L(0); PG8_MMA(0, 1, At, B1); PG8_BAR;
            PG8_LDA(At, 0, 1); PG8_STAGE(PG8_SA(0, 0), a2, voffA);
            PG8_BAR; PG8_WAIT_L(0); PG8_MMA(1, 0, At, B0); PG8_BAR; PG8_SCHED;
            PG8_STAGE(PG8_SB(0, 1), b2 + hstep, voffB);
            PG8_WAIT_V(6); PG8_BAR; PG8_MMA(1, 1, At, B1); PG8_BAR;
            PG8_LDB(B0, 1, 0); PG8_SCHED; PG8_LDA(At, 1, 0); PG8_STAGE(PG8_SA(0, 1), a2 + hstep, voffA);
            PG8_WAIT_L(8); PG8_BAR; PG8_WAIT_L(0); PG8_MMA(0, 0, At, B0); PG8_BAR; PG8_SCHED;
            PG8_LDB(B1, 1, 1); PG8_STAGE(PG8_SB(1, 0), b3, voffB);
            PG8_BAR; PG8_WAIT_L(0); PG8_MMA(0, 1, At, B1); PG8_BAR;
            PG8_LDA(At, 1, 1); PG8_STAGE(PG8_SA(1, 0), a3, voffA);
            PG8_BAR; PG8_WAIT_L(0); PG8_MMA(1, 0, At, B0); PG8_BAR; PG8_SCHED;
            PG8_STAGE(PG8_SB(1, 1), b3 + hstep, voffB);
            PG8_WAIT_V(6); PG8_BAR; PG8_MMA(1, 1, At, B1); PG8_BAR;
            }
        }
        if constexpr (ALIGN_EPI) { if (wr == 0) PG8_BAR; }
        if constexpr (!Epi::AFTER_DRAIN) { E(acc, cur, wr, wc, fr, fq); S.done(cur); }
        if (!has_next) break;
#pragma unroll
        for (int a = 0; a < 2; ++a)
#pragma unroll
            for (int b = 0; b < 2; ++b)
#pragma unroll
                for (int m = 0; m < 4; ++m)
#pragma unroll
                    for (int n = 0; n < 2; ++n) acc[a][b][m][n] = (f32x4){0.f, 0.f, 0.f, 0.f};
        cur = nxt; cA = nA; cB = nB; ++ui;
        if constexpr (ALIGN_EPI) { if (wr == 1) PG8_BAR; }
    }
    PG8_WAIT_V(0);
    if constexpr (!ALIGN_EPI) { if (wr == 0) PG8_BAR; }
    PG8_BAR;
    if constexpr (Epi::AFTER_DRAIN) { E.fused(acc, cur, wr, wc, fr, fq, lds, wid, lane); S.done(cur); }
#undef PG8_SA
#undef PG8_SB
#undef PG8_STAGE
#undef PG8_LDA
#undef PG8_LDB
#undef PG8_MMA
#undef PG8_WAIT_V
#undef PG8_WAIT_L
#undef PG8_BAR
#undef PG8_SCHED
}
}
namespace pg8 {
template <class F> struct EpiAdapt {
    static constexpr bool PERM = true, AFTER_DRAIN = false; F f;
    __device__ __forceinline__ void operator()(const f32x4 (&acc)[2][2][4][2], const Unit& u, int wr, int wc, int fr, int fq) const {
        const int c = wc * 32 + fq * 8;
#pragma unroll
        for (int ai = 0; ai < 2; ++ai)
#pragma unroll
            for (int m = 0; m < 4; ++m) {
                const int row = u.pm * BM + ai * HALF + wr * 64 + m * 16 + fr;
                float lo[8], hi[8];
#pragma unroll
                for (int j = 0; j < 4; ++j) { lo[j] = acc[ai][0][m][0][j]; lo[4 + j] = acc[ai][0][m][1][j]; hi[j] = acc[ai][1][m][0][j]; hi[4 + j] = acc[ai][1][m][1][j]; }
                f(row, u.pn, c, lo, hi);
            }
    }
};
}

typedef unsigned short bf16_t;
typedef short bf16x8 __attribute__((ext_vector_type(8)));
typedef float f32x4 __attribute__((ext_vector_type(4)));
typedef unsigned u32x4 __attribute__((ext_vector_type(4)));
#define LAS __attribute__((address_space(3)))

constexpr int D = 2048, NB = 4, S = 4096, M = NB * S, NIN = 7168, DFF = 5632, NGU = 2 * DFF;
constexpr float LN_EPS = 1e-5f, RMS_EPS = 1e-6f;
constexpr float ALPHA = 1.189207115002721f;
constexpr float LAMBDA_INIT = 0.2f;
constexpr float LOG2E = 1.4426950408889634f;
constexpr float QSCALE = 0.08838834764831845f;
constexpr int NWAVES = 8, NTHREADS = 512;
constexpr int LDS_BYTES = 147456;

constexpr size_t MiB = 1u << 20;
constexpr size_t OFF_MOD = 64 * 1024, OFF_LB = 320 * 1024, OFF_LAM = 328 * 1024;
constexpr size_t OFF_COS = 1 * MiB, OFF_SIN = 5 * MiB;
constexpr size_t OFF_WIN = 16 * MiB, OFF_WO = 44 * MiB, OFF_WGU = 52 * MiB, OFF_WD = 96 * MiB;
constexpr size_t OFF_U = 120 * MiB, OFF_MIX = 184 * MiB;
constexpr size_t OFF_QH = 248 * MiB, OFF_VH = 280 * MiB, OFF_GH = 312 * MiB, OFF_LOGF = 344 * MiB, OFF_QA = 408 * MiB, OFF_KA = 440 * MiB, OFF_VA = 472 * MiB;
constexpr size_t OFF_T1 = 248 * MiB, OFF_H1 = 376 * MiB, OFF_HFF = 184 * MiB;
constexpr size_t WS_NEED = 504 * MiB;

__device__ __forceinline__ float bf2f(bf16_t v) { return __uint_as_float((unsigned)v << 16); }
__device__ __forceinline__ bf16_t f2bf(float f) { unsigned u = __float_as_uint(f); return (bf16_t)((u + 0x7fffu + ((u >> 16) & 1u)) >> 16); }
__device__ __forceinline__ unsigned pk2(float lo, float hi) { return (unsigned)f2bf(lo) | ((unsigned)f2bf(hi) << 16); }
__device__ __forceinline__ float sigmoidf_(float x) { return 1.f / (1.f + __expf(-x)); }
__device__ __forceinline__ float wave_sum(float v) {
#pragma unroll
    for (int o = 1; o < 64; o <<= 1) v += __shfl_xor(v, o);
    return v;
}

struct Ptrs {
    const float *x, *c; const int* positions; const float *w_ada, *b_ada, *w_in, *lb_logits, *hg_norm_w, *lq1, *lk1, *lq2, *lk2, *subln_w, *w_out, *ln1_g, *ln1_b, *w_gate, *w_up, *w_down, *ln2_g, *ln2_b;
    float* out; float *mod, *lbv, *lam, *cosT, *sinT; bf16_t *WinT, *WoT, *WguT, *WdT, *U, *MIX, *Qh, *Vh, *Gh, *Qa, *Ka, *Va, *Hff; float *Logf, *T1, *H1;
};

struct Epi1 {
    bf16_t *Qh, *Vh, *Gh, *Qa, *Ka, *Va; float* Logf; const float *lbv, *cosT, *sinT;
    __device__ __forceinline__ void operator()(int row, int pn, int c, const float (&lo)[8], const float (&hi)[8]) const {
        const int seg = pn >> 2, pt = pn & 3;
        if (seg == 4 || seg == 5) {
            const int head = 2 * pt + (c >> 6), d0 = c & 63; const float sc = (seg == 4) ? QSCALE * LOG2E : 1.f;
            const f32x4 c0 = *(const f32x4*)(cosT + (size_t)row * 64 + d0), c1 = *(const f32x4*)(cosT + (size_t)row * 64 + d0 + 4);
            const f32x4 s0 = *(const f32x4*)(sinT + (size_t)row * 64 + d0), s1 = *(const f32x4*)(sinT + (size_t)row * 64 + d0 + 4);
            float o1[8], o2[8];
#pragma unroll
            for (int j = 0; j < 8; ++j) { const float cs = j < 4 ? c0[j & 3] : c1[j & 3], sn = j < 4 ? s0[j & 3] : s1[j & 3];
                o1[j] = (lo[j] * cs - hi[j] * sn) * sc; o2[j] = (hi[j] * cs + lo[j] * sn) * sc; }
            bf16_t* dst = (seg == 4 ? Qa : Ka) + (size_t)row * 1024 + head * 128 + d0;
            u32x4 w1 = {pk2(o1[0], o1[1]), pk2(o1[2], o1[3]), pk2(o1[4], o1[5]), pk2(o1[6], o1[7])}, w2 = {pk2(o2[0], o2[1]), pk2(o2[2], o2[3]), pk2(o2[4], o2[5]), pk2(o2[6], o2[7])};
            *(u32x4*)dst = w1; *(u32x4*)(dst + 64) = w2;
            return;
        }
#pragma unroll
        for (int h = 0; h < 2; ++h) {
            const int col = 256 * pt + 128 * h + c; float v[8];
#pragma unroll
            for (int j = 0; j < 8; ++j) v[j] = h ? hi[j] : lo[j];
            if (seg == 1) {
                float* dst = Logf + (size_t)row * 1024 + col;
                const f32x4 l0 = *(const f32x4*)(lbv + col), l1 = *(const f32x4*)(lbv + col + 4);
                f32x4 r0, r1;
#pragma unroll
                for (int j = 0; j < 8; ++j) { const float lb = j < 4 ? l0[j & 3] : l1[j & 3]; const float f = lb + (1.f - lb) * sigmoidf_(v[j]); if (j < 4) r0[j & 3] = __log2f(f); else r1[j & 3] = __log2f(f); }
                *(f32x4*)dst = r0; *(f32x4*)(dst + 4) = r1;
            } else {
                if (seg == 0) {
#pragma unroll
                    for (int j = 0; j < 8; ++j) v[j] = v[j] * sigmoidf_(v[j]) * QSCALE;
                } else if (seg == 3) {
#pragma unroll
                    for (int j = 0; j < 8; ++j) v[j] = sigmoidf_(v[j]);
                }
                bf16_t* dst = (seg == 0 ? Qh : seg == 2 ? Vh : seg == 3 ? Gh : Va) + (size_t)row * 1024 + col;
                u32x4 w = {pk2(v[0], v[1]), pk2(v[2], v[3]), pk2(v[4], v[5]), pk2(v[6], v[7])};
                *(u32x4*)dst = w;
            }
        }
    }
};
struct EpiRes {
    const float* res; const float* gate; float* out;
    __device__ __forceinline__ void operator()(int row, int pn, int c, const float (&lo)[8], const float (&hi)[8]) const {
        const int b = row / S;
#pragma unroll
        for (int h = 0; h < 2; ++h) { const size_t col = 256 * pn + 128 * h + c; const size_t o = (size_t)row * D + col;
            const f32x4 r0 = *(const f32x4*)(res + o), r1 = *(const f32x4*)(res + o + 4), g0 = *(const f32x4*)(gate + (size_t)b * 6 * D + col), g1 = *(const f32x4*)(gate + (size_t)b * 6 * D + col + 4);
            f32x4 v0, v1;
#pragma unroll
            for (int j = 0; j < 4; ++j) { v0[j] = h ? hi[j] : lo[j]; v1[j] = h ? hi[4 + j] : lo[4 + j]; }
            *(f32x4*)(out + o) = r0 * ALPHA + g0 * v0; *(f32x4*)(out + o + 4) = r1 * ALPHA + g1 * v1; }
    }
};
struct EpiSwiglu {
    bf16_t* Hff;
    __device__ __forceinline__ void operator()(int row, int pn, int c, const float (&lo)[8], const float (&hi)[8]) const {
        float v[8];
#pragma unroll
        for (int j = 0; j < 8; ++j) v[j] = lo[j] * sigmoidf_(lo[j]) * hi[j];
        u32x4 w = {pk2(v[0], v[1]), pk2(v[2], v[3]), pk2(v[4], v[5]), pk2(v[6], v[7])};
        *(u32x4*)(Hff + (size_t)row * DFF + 128 * pn + c) = w;
    }
};

__device__ __forceinline__ int src_col_win(int n) {
    const int pn = n >> 8, t = n & 255, seg = pn >> 2, pt = pn & 3;
    if (seg == 4 || seg == 5) { const int bj = t >> 7, o = t & 127; return seg * 1024 + (2 * pt + (o >> 6)) * 128 + (o & 63) + 64 * bj; }
    return n;
}
__device__ __forceinline__ void transpose_item(const float* Wsrc, int ldw, bf16_t* WTrow, int K, int k0, LAS float* scr, int lane) {
#pragma unroll 8
    for (int i = 0; i < 32; ++i) { const int kk = 2 * i + (lane >> 5); scr[kk * 33 + (lane & 31)] = Wsrc[(size_t)(k0 + kk) * ldw + (lane & 31)]; }
    asm volatile("s_waitcnt lgkmcnt(0)" ::: "memory");
    const int c = lane & 7;
#pragma unroll
    for (int j = 0; j < 4; ++j) { const int n = (lane >> 3) + 8 * j; const LAS float* s = scr + (8 * c) * 33 + n;
        u32x4 o; o.x = pk2(s[0 * 33], s[1 * 33]); o.y = pk2(s[2 * 33], s[3 * 33]); o.z = pk2(s[4 * 33], s[5 * 33]); o.w = pk2(s[6 * 33], s[7 * 33]);
        *(u32x4*)(WTrow + (size_t)n * K + k0 + 8 * c) = o; }
    asm volatile("s_waitcnt lgkmcnt(0)" ::: "memory");
}
__device__ __forceinline__ void p0_prologue(const Ptrs& P, LAS unsigned char* lds, int tid, int lane, int wave) {
    {
        LAS float* cond = (LAS float*)lds;
        LAS float* part = (LAS float*)(lds + 32768);
        for (int i = tid; i < NB * D; i += NTHREADS) { const float v = P.c[i]; cond[i] = v / (1.f + __expf(-v)); }
        __syncthreads();
        for (int chunk = blockIdx.x; chunk < 6 * D / 48; chunk += gridDim.x) {
            const int col = tid % 48, ks = tid / 48, e = chunk * 48 + col;
            if (tid < 480) {
                float a0 = 0, a1 = 0, a2 = 0, a3 = 0;
#pragma unroll 8
                for (int k = ks; k < D; k += 10) { const float w = P.w_ada[(size_t)k * (6 * D) + e]; a0 += cond[k] * w; a1 += cond[D + k] * w; a2 += cond[2 * D + k] * w; a3 += cond[3 * D + k] * w; }
                LAS float* pp = part + (ks * 48 + col) * 4; pp[0] = a0; pp[1] = a1; pp[2] = a2; pp[3] = a3;
            }
            __syncthreads();
            if (tid < 192) { const int cc = tid % 48, b = tid / 48; float s = P.b_ada[chunk * 48 + cc];
#pragma unroll
                for (int q = 0; q < 10; ++q) s += part[(q * 48 + cc) * 4 + b];
                P.mod[(size_t)b * 6 * D + chunk * 48 + cc] = s; }
            __syncthreads();
        }
    }
    for (int gid = blockIdx.x * NTHREADS + tid; gid < M * 64; gid += gridDim.x * NTHREADS) {
        const int row = gid >> 6, i = gid & 63;
        const double inv = exp2(-(double)i * (13.287712379549449 / 64.0));
        const double rev = (double)P.positions[row] * inv * 0.15915494309189535;
        const float fr = (float)(rev - rint(rev));
        P.cosT[gid] = __builtin_amdgcn_cosf(fr); P.sinT[gid] = __builtin_amdgcn_sinf(fr);
    }
    if (blockIdx.x == 0) {
        for (int i = tid; i < 1024; i += NTHREADS) P.lbv[i] = 1.f / (1.f + __expf(P.lb_logits[1024 + i] - P.lb_logits[i]));
        if (tid == 0) { float s1 = 0, s2 = 0; for (int i = 0; i < 128; ++i) { s1 += P.lq1[i] * P.lk1[i]; s2 += P.lq2[i] * P.lk2[i]; } P.lam[0] = expf(s1) - expf(s2) + LAMBDA_INIT; }
    }
    {
        LAS float* scr = (LAS float*)(lds + wave * 16384);
        const int gw = blockIdx.x * NWAVES + wave, NGW = gridDim.x * NWAVES;
        constexpr int I_IN = (D / 64) * (NIN / 32), I_O = (D / 64) * (D / 32), I_GU = (D / 64) * (NGU / 32), I_D = (DFF / 64) * (D / 32);
        for (int it = gw; it < I_IN + I_O + I_GU + I_D; it += NGW) {
            int r = it;
            if (r < I_IN) { const int nb = r % (NIN / 32), kb = r / (NIN / 32), n0 = nb * 32; transpose_item(P.w_in + src_col_win(n0), NIN, P.WinT + (size_t)n0 * D, D, kb * 64, scr, lane); continue; } r -= I_IN;
            if (r < I_O) { const int nb = r % (D / 32), kb = r / (D / 32), n0 = nb * 32; transpose_item(P.w_out + n0, D, P.WoT + (size_t)n0 * D, D, kb * 64, scr, lane); continue; } r -= I_O;
            if (r < I_GU) { const int nb = r % (NGU / 32), kb = r / (NGU / 32), n0 = nb * 32, pn = n0 >> 8, t = n0 & 255;
                const float* src = (t < 128) ? P.w_gate + 128 * pn + t : P.w_up + 128 * pn + (t - 128);
                transpose_item(src, DFF, P.WguT + (size_t)n0 * D, D, kb * 64, scr, lane); continue; } r -= I_GU;
            { const int nb = r % (D / 32), kb = r / (D / 32), n0 = nb * 32; transpose_item(P.w_down + n0, D, P.WdT + (size_t)n0 * DFF, DFF, kb * 64, scr, lane); }
        }
    }
}

__device__ __forceinline__ void ln_stats(const f32x4 (&v)[8], float& mean, float& rstd) {
    float s = 0;
#pragma unroll
    for (int j = 0; j < 8; ++j) s += (v[j][0] + v[j][1]) + (v[j][2] + v[j][3]);
    mean = wave_sum(s) * (1.f / D); float q = 0;
#pragma unroll
    for (int j = 0; j < 8; ++j) { const f32x4 d = v[j] - mean; q += (d[0] * d[0] + d[1] * d[1]) + (d[2] * d[2] + d[3] * d[3]); }
    rstd = rsqrtf(wave_sum(q) * (1.f / D) + LN_EPS);
}
__device__ __forceinline__ void mod_store_bf16(const f32x4 (&v)[8], float mean, float rstd, const float* sc, const float* sh, bf16_t* dst, int lane) {
#pragma unroll
    for (int j = 0; j < 8; ++j) { const int col = 4 * lane + 256 * j; const f32x4 o = (v[j] - mean) * rstd * (*(const f32x4*)(sc + col) + 1.f) + *(const f32x4*)(sh + col);
        uint2 w; w.x = pk2(o[0], o[1]); w.y = pk2(o[2], o[3]); *(uint2*)(dst + col) = w; }
}
__device__ __forceinline__ void p1_ln_mod(const Ptrs& P, int lane, int wave) {
    for (int row = blockIdx.x * NWAVES + wave; row < M; row += gridDim.x * NWAVES) {
        const f32x4* xr = (const f32x4*)(P.x + (size_t)row * D) + lane; f32x4 v[8];
#pragma unroll
        for (int j = 0; j < 8; ++j) v[j] = xr[64 * j];
        float mean, rstd; ln_stats(v, mean, rstd);
        const float* mb = P.mod + (size_t)(row / S) * 6 * D;
        mod_store_bf16(v, mean, rstd, mb + D, mb, P.U + (size_t)row * D, lane);
    }
}
__device__ __forceinline__ void p5_ln1(const Ptrs& P, int lane, int wave) {
    for (int row = blockIdx.x * NWAVES + wave; row < M; row += gridDim.x * NWAVES) {
        const f32x4* xr = (const f32x4*)(P.T1 + (size_t)row * D) + lane; f32x4 v[8];
#pragma unroll
        for (int j = 0; j < 8; ++j) v[j] = xr[64 * j];
        float mean, rstd; ln_stats(v, mean, rstd);
#pragma unroll
        for (int j = 0; j < 8; ++j) { const int col = 4 * lane + 256 * j; v[j] = (v[j] - mean) * rstd * *(const f32x4*)(P.ln1_g + col) + *(const f32x4*)(P.ln1_b + col);
            *(f32x4*)(P.H1 + (size_t)row * D + col) = v[j]; }
        ln_stats(v, mean, rstd);
        const float* mb = P.mod + (size_t)(row / S) * 6 * D;
        mod_store_bf16(v, mean, rstd, mb + 4 * D, mb + 3 * D, P.U + (size_t)row * D, lane);
    }
}
__device__ __forceinline__ void p8_ln_final(const Ptrs& P, int lane, int wave) {
    for (int row = blockIdx.x * NWAVES + wave; row < M; row += gridDim.x * NWAVES) {
        f32x4* xr = (f32x4*)(P.out + (size_t)row * D) + lane; f32x4 v[8];
#pragma unroll
        for (int j = 0; j < 8; ++j) v[j] = xr[64 * j];
        float mean, rstd; ln_stats(v, mean, rstd);
#pragma unroll
        for (int j = 0; j < 8; ++j) { const int col = 4 * lane + 256 * j; xr[64 * j] = (v[j] - mean) * rstd * *(const f32x4*)(P.ln2_g + col) + *(const f32x4*)(P.ln2_b + col); }
    }
}

__device__ __forceinline__ void hgrn_simple_item(const Ptrs& P, int item, unsigned char* lds, int tid) {
    float* sf = (float*)lds; float* sk = sf + 128; float* sq = sk + 128; float* po = sq + 128  ; float* red = po + 512;
    const int b = item >> 3, h = item & 7, v = tid & 127, qd = tid >> 7;
    float St[32];
#pragma unroll
    for (int d = 0; d < 32; ++d) St[d] = 0.f;
    const float w = P.hg_norm_w[v];
    for (int t = 0; t < S; ++t) {
        const size_t off = (size_t)(b * S + t) * 1024 + h * 128 + v;
        if (qd == 0) { const float f = exp2f(P.Logf[off]); sf[v] = f; sk[v] = 1.f - f; sq[v] = bf2f(P.Qh[off]); }
        const float vv = bf2f(P.Vh[off]);
        __syncthreads();
        float o = 0.f;
#pragma unroll
        for (int d = 0; d < 32; ++d) { const int dd = qd * 32 + d; St[d] = sf[dd] * St[d] + sk[dd] * vv; o += St[d] * sq[dd]; }
        po[qd * 128 + v] = o;
        __syncthreads();
        if (qd == 0) { o = (po[v] + po[128 + v]) + (po[256 + v] + po[384 + v]); const float ss = wave_sum(o * o); if ((tid & 63) == 0) red[tid >> 6] = ss; }
        __syncthreads();
        if (qd == 0) { const float tot = red[0] + red[1]; const float gg = bf2f(P.Gh[off]);
            P.MIX[(size_t)(b * S + t) * D + h * 128 + v] = f2bf(o * rsqrtf(tot * (1.f / 128.f) + RMS_EPS) * w * gg); }
    }
    __syncthreads();
}
__device__ __forceinline__ void attn_simple_item(const Ptrs& P, int b, int h, int qp, unsigned char* lds, int tid) {
    const int half = tid >> 8, t8 = tid & 255, r = t8 >> 4, j = t8 & 15;
    unsigned char* base = lds + half * 61952;
    float (*qs)[128] = (float (*)[128])base; bf16_t (*ks)[130] = (bf16_t (*)[130])(base + 8192); bf16_t (*vs)[256] = (bf16_t (*)[256])(base + 8192 + 16640); float (*ps)[64] = (float (*)[64])(base + 8192 + 16640 + 32768);
    const int q0 = qp * 32 + half * 16, qpos = q0 + r;
    const float lam = P.lam[0];
    float res[16];
#pragma unroll
    for (int c = 0; c < 16; ++c) res[c] = 0.f;
    for (int sub = 0; sub < 2; ++sub) {
        const int hh = 2 * h + sub;
        __syncthreads();
        for (int i = t8; i < 16 * 128; i += 256) qs[i >> 7][i & 127] = bf2f(P.Qa[(size_t)(b * S + q0 + (i >> 7)) * 1024 + hh * 128 + (i & 127)]);
        float m = -1e30f, l = 0.f, o[16];
#pragma unroll
        for (int c = 0; c < 16; ++c) o[c] = 0.f;
        const int nt = (q0 + 15) / 64 + 1;
        for (int t = 0; t < nt; ++t) {
            __syncthreads();
            for (int i = t8; i < 64 * 128; i += 256) ks[i >> 7][i & 127] = P.Ka[(size_t)(b * S + t * 64 + (i >> 7)) * 1024 + hh * 128 + (i & 127)];
            for (int i = t8; i < 64 * 256; i += 256) vs[i >> 8][i & 255] = P.Va[(size_t)(b * S + t * 64 + (i >> 8)) * 1024 + h * 256 + (i & 255)];
            __syncthreads();
            float sc[4]; float mx = -1e30f;
#pragma unroll
            for (int i = 0; i < 4; ++i) { const int kk = j + 16 * i; float a = 0.f;
                for (int d = 0; d < 128; ++d) a += qs[r][d] * bf2f(ks[kk][d]);
                sc[i] = (t * 64 + kk <= qpos) ? a : -INFINITY; mx = fmaxf(mx, sc[i]); }
#pragma unroll
            for (int o_ = 1; o_ < 16; o_ <<= 1) mx = fmaxf(mx, __shfl_xor(mx, o_));
            const float mn = fmaxf(m, mx), alpha = exp2f(m - mn); m = mn;
            float psum = 0.f;
#pragma unroll
            for (int i = 0; i < 4; ++i) { const float p = exp2f(sc[i] - mn); ps[r][j + 16 * i] = p; psum += p; }
#pragma unroll
            for (int o_ = 1; o_ < 16; o_ <<= 1) psum += __shfl_xor(psum, o_);
            l = l * alpha + psum;
            __syncthreads();
#pragma unroll
            for (int c = 0; c < 16; ++c) o[c] *= alpha;
            for (int kk = 0; kk < 64; ++kk) { const float p = ps[r][kk];
#pragma unroll
                for (int c = 0; c < 16; ++c) o[c] += p * bf2f(vs[kk][16 * j + c]); }
        }
        const float il = 1.f / l, sg = sub ? -lam : 1.f;
#pragma unroll
        for (int c = 0; c < 16; ++c) res[c] += sg * o[c] * il;
    }
    float ss = 0.f;
#pragma unroll
    for (int c = 0; c < 16; ++c) ss += res[c] * res[c];
#pragma unroll
    for (int o_ = 1; o_ < 16; o_ <<= 1) ss += __shfl_xor(ss, o_);
    const float rs = rsqrtf(ss * (1.f / 256.f) + RMS_EPS) * (1.f - LAMBDA_INIT);
#pragma unroll
    for (int c = 0; c < 16; ++c) P.MIX[(size_t)(b * S + qpos) * D + 1024 + h * 256 + 16 * j + c] = f2bf(res[c] * rs * P.subln_w[16 * j + c]);
    __syncthreads();
}
__device__ __forceinline__ void p3_mixers_simple(const Ptrs& P, unsigned char* lds, int tid) {
    for (int it = blockIdx.x; it < 32; it += gridDim.x) hgrn_simple_item(P, it, lds, tid);
    for (int it = blockIdx.x; it < 2048; it += gridDim.x) {
        const int round = it >> 8, b = it >> 9, h = (it >> 7) & 3; int qp = it & 127; if (round & 1) qp = 127 - qp;
        attn_simple_item(P, b, h, qp, lds, tid);
    }
}

struct Args { const void* in[21]; float* out; unsigned char* ws; int ph_lo, ph_hi; };
constexpr int NPHASE = 9;
__global__ void __launch_bounds__(NTHREADS, 2) fwd_kernel(Args a) {
    extern __shared__ __attribute__((aligned(16))) unsigned char lds[];
    cg::grid_group grid = cg::this_grid();
    const int tid = threadIdx.x, lane = tid & 63, wave = __builtin_amdgcn_readfirstlane(tid >> 6);
    Ptrs P;
    P.x = (const float*)a.in[0]; P.c = (const float*)a.in[1]; P.positions = (const int*)a.in[2]; P.w_ada = (const float*)a.in[3]; P.b_ada = (const float*)a.in[4]; P.w_in = (const float*)a.in[5];
    P.lb_logits = (const float*)a.in[6]; P.hg_norm_w = (const float*)a.in[7]; P.lq1 = (const float*)a.in[8]; P.lk1 = (const float*)a.in[9]; P.lq2 = (const float*)a.in[10]; P.lk2 = (const float*)a.in[11];
    P.subln_w = (const float*)a.in[12]; P.w_out = (const float*)a.in[13]; P.ln1_g = (const float*)a.in[14]; P.ln1_b = (const float*)a.in[15]; P.w_gate = (const float*)a.in[16]; P.w_up = (const float*)a.in[17];
    P.w_down = (const float*)a.in[18]; P.ln2_g = (const float*)a.in[19]; P.ln2_b = (const float*)a.in[20];
    P.out = a.out; unsigned char* ws = a.ws;
    P.mod = (float*)(ws + OFF_MOD); P.lbv = (float*)(ws + OFF_LB); P.lam = (float*)(ws + OFF_LAM); P.cosT = (float*)(ws + OFF_COS); P.sinT = (float*)(ws + OFF_SIN);
    P.WinT = (bf16_t*)(ws + OFF_WIN); P.WoT = (bf16_t*)(ws + OFF_WO); P.WguT = (bf16_t*)(ws + OFF_WGU); P.WdT = (bf16_t*)(ws + OFF_WD);
    P.U = (bf16_t*)(ws + OFF_U); P.MIX = (bf16_t*)(ws + OFF_MIX); P.Qh = (bf16_t*)(ws + OFF_QH); P.Vh = (bf16_t*)(ws + OFF_VH); P.Gh = (bf16_t*)(ws + OFF_GH); P.Logf = (float*)(ws + OFF_LOGF);
    P.Qa = (bf16_t*)(ws + OFF_QA); P.Ka = (bf16_t*)(ws + OFF_KA); P.Va = (bf16_t*)(ws + OFF_VA); P.T1 = (float*)(ws + OFF_T1); P.H1 = (float*)(ws + OFF_H1); P.Hff = (bf16_t*)(ws + OFF_HFF);
    LAS unsigned char* ldsl = (LAS unsigned char*)lds;
    const int lo = a.ph_lo, hi = a.ph_hi;
#define IN(k) (lo <= (k) && (k) < hi)
#define SEAM(k) do { if (IN(k) && IN((k) + 1)) grid.sync(); } while (0)
    if (IN(0)) { p0_prologue(P, ldsl, tid, lane, wave); } SEAM(0);
    if (IN(1)) { p1_ln_mod(P, lane, wave); } SEAM(1);
    if (IN(2)) {
        pg8::Gemm g{P.U, P.WinT, M, NIN, D}; pg8::StaticOrder So; So.init(M, NIN, gridDim.x, blockIdx.x);
        pg8::EpiAdapt<Epi1> E{Epi1{P.Qh, P.Vh, P.Gh, P.Qa, P.Ka, P.Va, P.Logf, P.lbv, P.cosT, P.sinT}};
        pg8::gemm_phase<pg8::EpiAdapt<Epi1>, pg8::StaticOrder, true, true>(ldsl, g, So, E);
    } SEAM(2);
    if (IN(3)) { p3_mixers_simple(P, lds, tid); } SEAM(3);
    if (IN(4)) {
        pg8::Gemm g{P.MIX, P.WoT, M, D, D}; pg8::StaticOrder So; So.init(M, D, gridDim.x, blockIdx.x);
        pg8::EpiAdapt<EpiRes> E{EpiRes{P.x, P.mod + 2 * D, P.T1}};
        pg8::gemm_phase<pg8::EpiAdapt<EpiRes>, pg8::StaticOrder, true, true>(ldsl, g, So, E);
    } SEAM(4);
    if (IN(5)) { p5_ln1(P, lane, wave); } SEAM(5);
    if (IN(6)) {
        pg8::Gemm g{P.U, P.WguT, M, NGU, D}; pg8::StaticOrder So; So.init(M, NGU, gridDim.x, blockIdx.x);
        pg8::EpiAdapt<EpiSwiglu> E{EpiSwiglu{P.Hff}};
        pg8::gemm_phase<pg8::EpiAdapt<EpiSwiglu>, pg8::StaticOrder, true, true>(ldsl, g, So, E);
    } SEAM(6);
    if (IN(7)) {
        pg8::Gemm g{P.Hff, P.WdT, M, D, DFF}; pg8::StaticOrder So; So.init(M, D, gridDim.x, blockIdx.x);
        pg8::EpiAdapt<EpiRes> E{EpiRes{P.H1, P.mod + 5 * D, P.out}};
        pg8::gemm_phase<pg8::EpiAdapt<EpiRes>, pg8::StaticOrder, true, true>(ldsl, g, So, E);
    } SEAM(7);
    if (IN(8)) { p8_ln_final(P, lane, wave); }
#undef IN
#undef SEAM
}

#ifndef MK_N_LAUNCHES
#define MK_N_LAUNCHES 1
#endif
extern "C" void kernel_launch(void* const* d_in, const int* in_sizes, int n_in, void* d_out, int out_size, void* d_ws, size_t ws_size, hipStream_t stream) {
    static int grid = 0;
    if (grid == 0) {
        if (n_in != 21 || in_sizes[0] != M * D || out_size != M * D || ws_size < WS_NEED) { fprintf(stderr, "kernel_launch: unexpected shapes (n_in %d, in0 %d, out %d, ws %zu)\n", n_in, n_in > 0 ? in_sizes[0] : -1, out_size, ws_size); grid = -1; return; }
        int dev = 0, cus = 0, per_cu = 0;
        if (hipGetDevice(&dev) != hipSuccess || hipDeviceGetAttribute(&cus, hipDeviceAttributeMultiprocessorCount, dev) != hipSuccess) { fprintf(stderr, "kernel_launch: device query failed\n"); grid = -1; return; }
        if (hipFuncSetAttribute((const void*)fwd_kernel, hipFuncAttributeMaxDynamicSharedMemorySize, LDS_BYTES) != hipSuccess) { fprintf(stderr, "kernel_launch: hipFuncSetAttribute failed\n"); grid = -1; return; }
        if (hipOccupancyMaxActiveBlocksPerMultiprocessor(&per_cu, (const void*)fwd_kernel, NTHREADS, LDS_BYTES) != hipSuccess || per_cu < 1) { fprintf(stderr, "kernel_launch: occupancy query says %d blocks per CU\n", per_cu); (void)hipGetLastError(); per_cu = 1; }
        grid = cus * (per_cu < 1 ? 1 : 1);
    }
    if (grid < 0) return;
    Args a{};
    for (int i = 0; i < 21; ++i) a.in[i] = d_in[i];
    a.out = (float*)d_out; a.ws = (unsigned char*)d_ws;
#if MK_N_LAUNCHES == 1
    a.ph_lo = 0; a.ph_hi = NPHASE;
    void* args[] = {&a};
    hipError_t e = hipLaunchCooperativeKernel((const void*)fwd_kernel, dim3(grid), dim3(NTHREADS), args, LDS_BYTES, stream);
    if (e != hipSuccess) fprintf(stderr, "kernel_launch: cooperative launch failed: %s (grid %d)\n", hipGetErrorString(e), grid);
#else
    for (int p = 0; p < NPHASE; ++p) { a.ph_lo = p; a.ph_hi = p + 1; hipLaunchKernelGGL(fwd_kernel, dim3(grid), dim3(NTHREADS), LDS_BYTES, stream, a); }
#endif
}
```

```cpp
#include <hip/hip_runtime.h>
#include <hip/hip_cooperative_groups.h>
#include <hip/hip_bf16.h>
#include <stdint.h>
#include <cstdio>
namespace cg = cooperative_groups;
namespace pg8 {
#define PG8_LAS __attribute__((address_space(3)))
typedef unsigned short bf16_t;
typedef short bf16x8 __attribute__((ext_vector_type(8)));
typedef float f32x4 __attribute__((ext_vector_type(4)));
typedef unsigned u32x4 __attribute__((ext_vector_type(4)));
constexpr int BM = 256, BK = 64, HALF = 128, HTB = HALF * BK * 2  , STAGE_BYTES = 8 * HTB, NXCD = 8, WGM = 8;

__host__ __device__ __forceinline__ int lds_byte(int r, int c) { const int st = (r >> 4) * 2 + (c >> 5), rr = r & 15, cc = c & 31, ob = rr * 64 + cc * 2; return st * 1024 + (ob ^ (((ob >> 9) & 1) << 5)); }
__host__ __device__ __forceinline__ void stage_rc(int b, int& R, int& C) { const int st = b / 1024, sb = b % 1024, swz = sb ^ (((sb >> 9) & 1) << 5); R = (st >> 1) * 16 + swz / 64; C = (st & 1) * 32 + (swz % 64) / 2; }
__host__ __device__ __forceinline__ int perm32(int rho) { const int n = rho >> 4, i = rho & 15; return 8 * (i >> 2) + 4 * n + (i & 3); }

struct Unit { int pm, pn; };
struct Gemm { const bf16_t* A; const bf16_t* Bt; int M, N, K; };

struct StaticOrder {
    int nM, nN, nwg, G, c;
    __host__ __device__ void init(int M, int N, int G_, int c_) { nM = M / BM; nN = N / BM; nwg = nM * nN; G = G_; c = c_; }
    __host__ __device__ bool next(int i, Unit& u) const {
        const long L = (long)i * G + c; if (L >= nwg) return false;
        int wgid = (int)L; { const int q = nwg / NXCD, r = nwg % NXCD, xcd = wgid % NXCD, off = wgid / NXCD; wgid = (xcd < r ? xcd * (q + 1) : r * (q + 1) + (xcd - r) * q) + off; }
        const int nig = WGM * nN, gid = wgid / nig, fm = gid * WGM, gsz = (nM - fm) < WGM ? (nM - fm) : WGM;
        u.pm = fm + ((wgid % nig) % gsz); u.pn = (wgid % nig) / gsz; return true;
    }
    __device__ __forceinline__ void a_ready(const Unit&) const {}
    __device__ __forceinline__ void done(const Unit&) const {}
};
template <class Epi, class Sched, bool ALIGN_EPI = false, bool SP2 = false>
__device__ __forceinline__ void gemm_phase(PG8_LAS unsigned char* lds, const Gemm g, const Sched& S, const Epi& E, const int tid_in) {
    const int tid = tid_in, wid = __builtin_amdgcn_readfirstlane(tid >> 6), lane = tid & 63, wr = wid >> 2, wc = wid & 3, fr = lane & 15, fq = lane >> 4;
    const int K = g.K, nt = K / BK;
    unsigned voffA[2], voffB[2];
#pragma unroll
    for (int i = 0; i < 2; ++i) { int R, C; stage_rc(tid * 16 + i * 8192, R, C); const int Rb = Epi::PERM ? ((R & ~31) + perm32(R & 31)) : R;
        voffA[i] = (unsigned)(R * K + C) * 2u; voffB[i] = (unsigned)(Rb * K + C) * 2u; }
    const size_t kstep = (size_t)(BK * 2);
    const size_t hstep = (size_t)HALF * K * 2;
    const size_t tstep = 2 * hstep;
    const unsigned ldsw = (unsigned)wid * 1024u;
    const int aoff = lds_byte(wr * 64 + fr, fq * 8), boff = lds_byte(wc * 32 + fr, fq * 8);
#define PG8_SA(b, h) (((b) * 2 + (h)) * HTB)
#define PG8_SB(b, h) ((4 + (b) * 2 + (h)) * HTB)
#define PG8_STAGE(bufoff, gbase, voff) do { _Pragma("unroll") for (int _i = 0; _i < 2; ++_i) \
        __builtin_amdgcn_global_load_lds((const unsigned*)((const char*)(gbase) + (voff)[_i]), (PG8_LAS unsigned*)(lds + (bufoff) + ldsw + _i * 8192), 16, 0, 0); } while (0)
#define PG8_LDA(dst, b, h) do { _Pragma("unroll") for (int m = 0; m < 4; ++m) _Pragma("unroll") for (int k = 0; k < 2; ++k) dst[m][k] = *(const PG8_LAS bf16x8*)(lds + PG8_SA(b, h) + aoff + m * 2048 + k * 1024); } while (0)
#define PG8_LDB(dst, b, h) do { _Pragma("unroll") for (int n = 0; n < 2; ++n) _Pragma("unroll") for (int k = 0; k < 2; ++k) dst[n][k] = *(const PG8_LAS bf16x8*)(lds + PG8_SB(b, h) + boff + n * 2048 + k * 1024); } while (0)
#define PG8_MMA(ai, bj, At, Bt) do { __builtin_amdgcn_s_setprio(1); _Pragma("unroll") for (int m = 0; m < 4; ++m) _Pragma("unroll") for (int n = 0; n < 2; ++n) _Pragma("unroll") for (int k = 0; k < 2; ++k) \
        acc[ai][bj][m][n] = __builtin_amdgcn_mfma_f32_16x16x32_bf16(Bt[n][k], At[m][k], acc[ai][bj][m][n], 0, 0, 0); __builtin_amdgcn_s_setprio(0); } while (0)
#define PG8_WAIT_V(n) asm volatile("s_waitcnt vmcnt(" #n ")" ::: "memory")
#define PG8_WAIT_L(n) asm volatile("s_waitcnt lgkmcnt(" #n ")" ::: "memory")
#define PG8_BAR __builtin_amdgcn_s_barrier()
#define PG8_SCHED __builtin_amdgcn_sched_barrier(0)
    Unit cur, nxt; int ui = 0;
    if (!S.next(0, cur)) return;
    f32x4 acc[2][2][4][2];
#pragma unroll
    for (int a = 0; a < 2; ++a)
#pragma unroll
        for (int b = 0; b < 2; ++b)
#pragma unroll
            for (int m = 0; m < 4; ++m)
#pragma unroll
                for (int n = 0; n < 2; ++n) acc[a][b][m][n] = (f32x4){0.f, 0.f, 0.f, 0.f};
    bf16x8 At[4][2], B0[2][2], B1[2][2];
    const char* cA = (const char*)g.A + (size_t)cur.pm * tstep; const char* cB = (const char*)g.Bt + (size_t)cur.pn * tstep;
    S.a_ready(cur);
    if constexpr (SP2) {
        PG8_STAGE(PG8_SB(0, 0), cB, voffB); PG8_STAGE(PG8_SB(0, 1), cB + hstep, voffB); PG8_STAGE(PG8_SA(0, 0), cA, voffA); PG8_STAGE(PG8_SA(0, 1), cA + hstep, voffA);
        if (wr == 1) PG8_BAR;
        PG8_WAIT_V(2); PG8_BAR;
        PG8_STAGE(PG8_SB(1, 0), cB + kstep, voffB); PG8_STAGE(PG8_SA(1, 0), cA + kstep, voffA); PG8_STAGE(PG8_SB(1, 1), cB + hstep + kstep, voffB);
        PG8_WAIT_V(6); PG8_BAR;
    } else {
        PG8_STAGE(PG8_SB(0, 0), cB, voffB); PG8_STAGE(PG8_SA(0, 0), cA, voffA); PG8_STAGE(PG8_SB(0, 1), cB + hstep, voffB); PG8_STAGE(PG8_SA(0, 1), cA + hstep, voffA);
        if (wr == 1) PG8_BAR;
        PG8_WAIT_V(4); PG8_BAR;
        PG8_STAGE(PG8_SB(1, 0), cB + kstep, voffB); PG8_STAGE(PG8_SA(1, 0), cA + kstep, voffA); PG8_STAGE(PG8_SB(1, 1), cB + hstep + kstep, voffB);
        PG8_WAIT_V(6); PG8_BAR;
    }
    for (;;) {
        const bool has_next = S.next(ui + 1, nxt);
        const char* nA = has_next ? (const char*)g.A + (size_t)nxt.pm * tstep : cA; const char* nB = has_next ? (const char*)g.Bt + (size_t)nxt.pn * tstep : cB;
        for (int t = 0; t < nt; t += 2) {
            const bool last = (t == nt - 2);
            const char* a1 = cA + (size_t)(t + 1) * kstep;
            const char* a2 = last ? nA : cA + (size_t)(t + 2) * kstep; const char* b2 = last ? nB : cB + (size_t)(t + 2) * kstep;
            const char* a3 = a2 + kstep; const char* b3 = b2 + kstep;
            if (last && has_next) S.a_ready(nxt);
            if constexpr (SP2) {
            PG8_LDB(B0, 0, 0); PG8_LDB(B1, 0, 1); PG8_SCHED; PG8_LDA(At, 0, 0); PG8_STAGE(PG8_SA(1, 1), a1 + hstep, voffA);
            PG8_WAIT_V(8); PG8_WAIT_L(0); PG8_BAR; PG8_MMA(0, 0, At, B0); PG8_MMA(0, 1, At, B1); PG8_BAR; PG8_SCHED;
            PG8_LDA(At, 0, 1); PG8_STAGE(PG8_SB(0, 0), b2, voffB); PG8_STAGE(PG8_SB(0, 1), b2 + hstep, voffB); PG8_STAGE(PG8_SA(0, 0), a2, voffA);
            PG8_WAIT_V(8); PG8_WAIT_L(0); PG8_BAR; PG8_MMA(1, 0, At, B0); PG8_MMA(1, 1, At, B1); PG8_BAR; PG8_SCHED;
            PG8_LDB(B0, 1, 0); PG8_LDB(B1, 1, 1); PG8_SCHED; PG8_LDA(At, 1, 0); PG8_STAGE(PG8_SA(0, 1), a2 + hstep, voffA);
            PG8_WAIT_V(8); PG8_WAIT_L(0); PG8_BAR; PG8_MMA(0, 0, At, B0); PG8_MMA(0, 1, At, B1); PG8_BAR; PG8_SCHED;
            PG8_LDA(At, 1, 1); PG8_STAGE(PG8_SB(1, 0), b3, voffB); PG8_STAGE(PG8_SB(1, 1), b3 + hstep, voffB); PG8_STAGE(PG8_SA(1, 0), a3, voffA);
            PG8_WAIT_V(8); PG8_WAIT_L(0); PG8_BAR; PG8_MMA(1, 0, At, B0); PG8_MMA(1, 1, At, B1); PG8_BAR; PG8_SCHED;
            } else {
            PG8_LDB(B0, 0, 0); PG8_SCHED; PG8_LDA(At, 0, 0); PG8_STAGE(PG8_SA(1, 1), a1 + hstep, voffA);
            PG8_WAIT_L(8); PG8_BAR; PG8_WAIT_L(0); PG8_MMA(0, 0, At, B0); PG8_BAR; PG8_SCHED;
            PG8_LDB(B1, 0, 1); PG8_STAGE(PG8_SB(0, 0), b2, voffB);
            PG8_BAR; PG8_WAIT_L(0); PG8_MMA(0, 1, At, B1); PG8_BAR;
            PG8_LDA(At, 0, 1); PG8_STAGE(PG8_SA(0, 0), a2, voffA);
            PG8_BAR; PG8_WAIT_L(0); PG8_MMA(1, 0, At, B0); PG8_BAR; PG8_SCHED;
            PG8_STAGE(PG8_SB(0, 1), b2 + hstep, voffB);
            PG8_WAIT_V(6); PG8_BAR; PG8_MMA(1, 1, At, B1); PG8_BAR;
            PG8_LDB(B0, 1, 0); PG8_SCHED; PG8_LDA(At, 1, 0); PG8_STAGE(PG8_SA(0, 1), a2 + hstep, voffA);
            PG8_WAIT_L(8); PG8_BAR; PG8_WAIT_L(0); PG8_MMA(0, 0, At, B0); PG8_BAR; PG8_SCHED;
            PG8_LDB(B1, 1, 1); PG8_STAGE(PG8_SB(1, 0), b3, voffB);
            PG8_BAR; PG8_WAIT_L(0); PG8_MMA(0, 1, At, B1); PG8_BAR;
            PG8_LDA(At, 1, 1); PG8_STAGE(PG8_SA(1, 0), a3, voffA);
            PG8_BAR; PG8_WAIT_L(0); PG8_MMA(1, 0, At, B0); PG8_BAR; PG8_SCHED;
            PG8_STAGE(PG8_SB(1, 1), b3 + hstep, voffB);
            PG8_WAIT_V(6); PG8_BAR; PG8_MMA(1, 1, At, B1); PG8_BAR;
            }
        }
        if constexpr (ALIGN_EPI) { if (wr == 0) PG8_BAR; }
        if constexpr (!Epi::AFTER_DRAIN) { E(acc, cur, wr, wc, fr, fq); S.done(cur); }
        if (!has_next) break;
#pragma unroll
        for (int a = 0; a < 2; ++a)
#pragma unroll
            for (int b = 0; b < 2; ++b)
#pragma unroll
                for (int m = 0; m < 4; ++m)
#pragma unroll
                    for (int n = 0; n < 2; ++n) acc[a][b][m][n] = (f32x4){0.f, 0.f, 0.f, 0.f};
        cur = nxt; cA = nA; cB = nB; ++ui;
        if constexpr (ALIGN_EPI) { if (wr == 1) PG8_BAR; }
    }
    PG8_WAIT_V(0);
    if constexpr (!ALIGN_EPI) { if (wr == 0) PG8_BAR; }
    PG8_BAR;
    if constexpr (Epi::AFTER_DRAIN) { E.fused(acc, cur, wr, wc, fr, fq, lds, wid, lane); S.done(cur); }
#undef PG8_SA
#undef PG8_SB
#undef PG8_STAGE
#undef PG8_LDA
#undef PG8_LDB
#undef PG8_MMA
#undef PG8_WAIT_V
#undef PG8_WAIT_L
#undef PG8_BAR
#undef PG8_SCHED
}
}
namespace attn {
constexpr int D = 128, LDR = 1024;
constexpr float SCALE = 0.6931471805599453f;
constexpr float THR = 8.f;
constexpr bool WSKIP = false;
constexpr int NW = 8, QBLK = 32, KVBLK = 64, QB = NW * QBLK;
constexpr int SHM_V = KVBLK * D * 2, SHM_K = KVBLK * D * 2;
constexpr int LDS_BYTES = 2 * SHM_V + 2 * SHM_K + NW * 64 * 4;
using bf16 = __hip_bfloat16;
typedef short bf16x8 __attribute__((ext_vector_type(8)));
typedef short s16x4 __attribute__((ext_vector_type(4)));
typedef float f32x16 __attribute__((ext_vector_type(16)));
typedef float f32x4 __attribute__((ext_vector_type(4)));
typedef unsigned u32x4 __attribute__((ext_vector_type(4)));
template <class A, class Bt> struct same_t { static constexpr bool v = false; };
template <class A> struct same_t<A, A> { static constexpr bool v = true; };

#define KSWZ(row, colB) ((row) * 256 + ((colB) ^ (((row) & 7) << 4)))
#define SBAR() __builtin_amdgcn_sched_barrier(0)
__device__ __forceinline__ int v_st(int k, int c) { const int kk = (k & ~0xC) | ((k & 4) << 1) | ((k & 8) >> 1); return ((kk >> 3) * 4 + (c >> 5)) * 512 + ((kk & 7) * 32 + (c & 31)) * 2; }
__device__ __forceinline__ int v_rd_base(int lane) { return ((lane & 3) << 3) | (((lane >> 2) & 3) << 6) | (((lane >> 4) & 1) << 5) | (((lane >> 5) & 1) << 8); }
constexpr int v_rd_off(int d0, int ks, int half) { return d0 * 512 + ks * 4096 + half * 2048; }
__device__ __forceinline__ int crow(int r, int hi) { return (r & 3) + 8 * (r >> 2) + 4 * hi; }
__device__ __forceinline__ unsigned cvtpk(float lo, float hi) {
    unsigned r; asm volatile("v_cvt_pk_bf16_f32 %0, %1, %2" : "=v"(r) : "v"(lo), "v"(hi)); return r;
}
__device__ __forceinline__ bf16x8 pack8(f32x4 a, f32x4 b) {
    u32x4 w = {cvtpk(a[0], a[1]), cvtpk(a[2], a[3]), cvtpk(b[0], b[1]), cvtpk(b[2], b[3])};
    return *reinterpret_cast<bf16x8*>(&w);
}
template <class T> __device__ __forceinline__ bf16x8 load8(const T* p) {
    if constexpr (same_t<T, float>::v) { return pack8(*(const f32x4*)p, *(const f32x4*)(p + 4)); }
    else { return *reinterpret_cast<const bf16x8*>(p); }
}
__device__ __forceinline__ void mask_tile(f32x16& p0, f32x16& p1, int dq, unsigned W) {
    const float NEG = -__builtin_inff();
#pragma unroll
    for (int r = 0; r < 16; ++r) {
        const int c = (r & 3) + 8 * (r >> 2);
        if ((unsigned)(dq - c) >= W) p0[r] = NEG;
        if ((unsigned)(dq - c - 32) >= W) p1[r] = NEG;
    }
}
__device__ __forceinline__ void partialSM(f32x16& p0, f32x16& p1, float& m_reg, float& mn, float& alpha) {
    float pmax = p0[0]; for (int r = 1; r < 16; ++r) pmax = fmaxf(pmax, p0[r]); for (int r = 0; r < 16; ++r) pmax = fmaxf(pmax, p1[r]);
    { auto rr = __builtin_amdgcn_permlane32_swap(__float_as_uint(pmax), __float_as_uint(pmax), false, false);
      pmax = fmaxf(__uint_as_float(rr[0]), __uint_as_float(rr[1])); }
    constexpr float C2 = 1.4426950408889634f * SCALE;
    if (__builtin_expect(__all((pmax - m_reg) * SCALE <= THR), 1)) { mn = m_reg; alpha = 1.f; }
    else { mn = fmaxf(m_reg, pmax); alpha = __builtin_amdgcn_exp2f((m_reg - mn) * C2); m_reg = mn; }
    const float mnL = -mn * C2;
    for (int r = 0; r < 16; ++r) p0[r] = fmaf(p0[r], C2, mnL); for (int r = 0; r < 16; ++r) p1[r] = fmaf(p1[r], C2, mnL);
    for (int r = 0; r < 16; ++r) p0[r] = __builtin_amdgcn_exp2f(p0[r]);
}
__device__ __forceinline__ void finishSM(f32x16& p0, f32x16& p1, float alpha, float& l_reg, bf16x8& pa0, bf16x8& pa1, bf16x8& pa2, bf16x8& pa3) {
    for (int r = 0; r < 16; ++r) p1[r] = __builtin_amdgcn_exp2f(p1[r]);
    float ps = 0; for (int r = 0; r < 16; ++r) ps += p0[r]; for (int r = 0; r < 16; ++r) ps += p1[r];
    { auto rr = __builtin_amdgcn_permlane32_swap(__float_as_uint(ps), __float_as_uint(ps), false, false);
      ps = __uint_as_float(rr[0]) + __uint_as_float(rr[1]); }
    l_reg = l_reg * alpha + ps;
#define PK4(P, B_, OUT) do { unsigned a0 = cvtpk(P[B_+0], P[B_+1]), a1 = cvtpk(P[B_+2], P[B_+3]);                          \
        unsigned b0 = cvtpk(P[B_+4], P[B_+5]), b1 = cvtpk(P[B_+6], P[B_+7]);                                             \
        auto r0 = __builtin_amdgcn_permlane32_swap(a0, b0, false, false); auto r1 = __builtin_amdgcn_permlane32_swap(a1, b1, false, false); \
        u32x4 w = {r0[0], r1[0], r0[1], r1[1]}; OUT = *reinterpret_cast<bf16x8*>(&w); } while (0)
    PK4(p0, 0, pa0); PK4(p0, 8, pa1); PK4(p1, 0, pa2); PK4(p1, 8, pa3);
#undef PK4
}
template <int KB, bool SK>
__device__ __forceinline__ void qkt(f32x16& p0, f32x16& p1, const char* K_lds, int r32, int hi, const bf16x8* qr, bool act) {
    if (SK && !act) { const float NEG = -__builtin_inff();
#pragma unroll
        for (int r = 0; r < 16; ++r) { p0[r] = NEG; p1[r] = NEG; } return; }
    p0 = f32x16{}; p1 = f32x16{};
    const char* kb[4];
#pragma unroll
    for (int dd = 0; dd < 4; ++dd) kb[dd] = K_lds + KB * SHM_K + KSWZ(r32, (dd * 16 + hi * 8) * 2);
#pragma unroll
    for (int d0 = 0; d0 < 8; ++d0) { const char* a = kb[d0 & 3] + (d0 >> 2) * 128;
        bf16x8 b0 = *reinterpret_cast<const bf16x8*>(a);
        bf16x8 b1 = *reinterpret_cast<const bf16x8*>(a + 32 * 256);
        p0 = __builtin_amdgcn_mfma_f32_32x32x16_bf16(b0, qr[d0], p0, 0, 0, 0);
        p1 = __builtin_amdgcn_mfma_f32_32x32x16_bf16(b1, qr[d0], p1, 0, 0, 0); }
}
template <int VB, bool SK>
__device__ __forceinline__ void pv_tile(f32x16* o, int vb0, bf16x8 pa0, bf16x8 pa1, bf16x8 pa2, bf16x8 pa3, bool act) {
    if (SK && !act) return;
#define TRRD(dst, off) asm volatile("ds_read_b64_tr_b16 %0, %1 offset:%2" : "=&v"(dst) : "v"(vb0), "i"(off) : "memory")
#define PV_D0(d0) do { s16x4 l0, l1, l2, l3, h0, h1, h2, h3; constexpr int b_ = VB * SHM_V + v_rd_off(d0, 0, 0);     \
        TRRD(l0, b_); TRRD(h0, b_ + 2048); TRRD(l1, b_ + 4096); TRRD(h1, b_ + 6144); TRRD(l2, b_ + 8192); TRRD(h2, b_ + 10240); TRRD(l3, b_ + 12288); TRRD(h3, b_ + 14336); \
        asm volatile("s_waitcnt lgkmcnt(0)" ::: "memory"); SBAR();                 \
        o[d0] = __builtin_amdgcn_mfma_f32_32x32x16_bf16(pa0, (bf16x8){l0[0], l0[1], l0[2], l0[3], h0[0], h0[1], h0[2], h0[3]}, o[d0], 0, 0, 0);   \
        o[d0] = __builtin_amdgcn_mfma_f32_32x32x16_bf16(pa1, (bf16x8){l1[0], l1[1], l1[2], l1[3], h1[0], h1[1], h1[2], h1[3]}, o[d0], 0, 0, 0);   \
        o[d0] = __builtin_amdgcn_mfma_f32_32x32x16_bf16(pa2, (bf16x8){l2[0], l2[1], l2[2], l2[3], h2[0], h2[1], h2[2], h2[3]}, o[d0], 0, 0, 0);   \
        o[d0] = __builtin_amdgcn_mfma_f32_32x32x16_bf16(pa3, (bf16x8){l3[0], l3[1], l3[2], l3[3], h3[0], h3[1], h3[2], h3[3]}, o[d0], 0, 0, 0); } while (0)
    PV_D0(0); PV_D0(1); PV_D0(2); PV_D0(3);
#undef PV_D0
#undef TRRD
}

template <class TIn, class TOut> struct BlockRef { const TIn* Q; const TIn* K; const TIn* V; TOut* O; int P0; };
template <class TIn> struct Seam {
    bf16x8 qr[8];
    bf16x8 st_v0, st_v1, st_k0, st_k1; f32x4 sf0, sf1, sf2, sf3;
    f32x4 tq[16];
};
__device__ __forceinline__ int swa_jlo(int P0, int W) { const int lowk = P0 - W + 1; return lowk > 0 ? lowk / KVBLK : 0; }
#define ROW(p, k0, rr) ((p) + (size_t)((k0) + (rr)) * LDR + sc)
#define VMW() asm volatile("s_waitcnt vmcnt(0)" ::: "memory")
#define VMWN(n) asm volatile("s_waitcnt vmcnt(%0)" :: "i"(n) : "memory")
#define SLOAD_H(Kp, Vp, k0) do { S.st_v0 = load8<TIn>(ROW(Vp, k0, sr)); S.st_v1 = load8<TIn>(ROW(Vp, k0, 32 + sr));              \
                         S.st_k0 = load8<TIn>(ROW(Kp, k0, sr)); S.st_k1 = load8<TIn>(ROW(Kp, k0, 32 + sr)); } while (0)
#define SWRITE_HK(bf) do { *(bf16x8*)(K_lds + (bf) * SHM_K + kws) = S.st_k0; *(bf16x8*)(K_lds + (bf) * SHM_K + kws + 32 * 256) = S.st_k1; } while (0)
#define SWRITE_HV(bf) do { *(bf16x8*)(V_lds + (bf) * SHM_V + vst0) = S.st_v0; *(bf16x8*)(V_lds + (bf) * SHM_V + vst1) = S.st_v1; } while (0)
#define SWRITE_H(bf) do { SWRITE_HV(bf); SWRITE_HK(bf); } while (0)
#define SLOAD_F(p, k0) do { S.sf0 = *(const f32x4*)ROW(p, k0, sr); S.sf1 = *(const f32x4*)(ROW(p, k0, sr) + 4);                \
                            S.sf2 = *(const f32x4*)ROW(p, k0, 32 + sr); S.sf3 = *(const f32x4*)(ROW(p, k0, 32 + sr) + 4); } while (0)
#define SWRITE_KF(bf) do { *(bf16x8*)(K_lds + (bf) * SHM_K + kws) = pack8(S.sf0, S.sf1); *(bf16x8*)(K_lds + (bf) * SHM_K + kws + 32 * 256) = pack8(S.sf2, S.sf3); } while (0)
#define SWRITE_VF(bf) do { *(bf16x8*)(V_lds + (bf) * SHM_V + vst0) = pack8(S.sf0, S.sf1); *(bf16x8*)(V_lds + (bf) * SHM_V + vst1) = pack8(S.sf2, S.sf3); } while (0)
template <class TIn, class TOut>
__device__ __forceinline__ void causal_swa_prime(const BlockRef<TIn, TOut>& cur, int W, char* lds, Seam<TIn>& S, const int tid_in) {
    constexpr bool F32 = same_t<TIn, float>::v;
    const int tid = tid_in, wid = __builtin_amdgcn_readfirstlane(tid >> 6), lane = tid & 63, r32 = lane & 31, hi = lane >> 5;
    const int sr = tid >> 4, sc = (tid & 15) * 8, kws = KSWZ(sr, sc * 2); char* K_lds = lds + 2 * SHM_V;
    const int kb0 = swa_jlo(cur.P0, W) * KVBLK;
    for (int d0 = 0; d0 < 8; ++d0) S.qr[d0] = load8<TIn>(cur.Q + (size_t)(wid * QBLK + r32) * LDR + d0 * 16 + hi * 8);
    if constexpr (F32) { SLOAD_F((const float*)cur.K, kb0); VMW(); SWRITE_KF(0); SBAR(); SLOAD_F((const float*)cur.V, kb0); }
    else { SLOAD_H(cur.K, cur.V, kb0); VMW(); SWRITE_HK(0); }
    __syncthreads();
}
template <class TIn, class TOut>
__device__ __forceinline__ void causal_swa_block(const BlockRef<TIn, TOut>& cur, const BlockRef<TIn, TOut>& nxt, int skv, int W, char* lds, Seam<TIn>& S, const int tid_in) {
    constexpr bool F32 = same_t<TIn, float>::v;
    const int tid = tid_in, wid = __builtin_amdgcn_readfirstlane(tid >> 6), lane = tid & 63, r32 = lane & 31, hi = lane >> 5;
    const int j_lo = swa_jlo(cur.P0, W);
    int j_hi = (cur.P0 + QB - 1) / KVBLK + 1; if (j_hi > skv / KVBLK) j_hi = skv / KVBLK;
    const int NT = j_hi - j_lo;
    const int kbn = swa_jlo(nxt.P0, W) * KVBLK;
    const int qlo = cur.P0 + wid * QBLK, qm = qlo + r32 - 4 * hi;
    char* V_lds = lds; char* K_lds = lds + 2 * SHM_V;
    float* ws = (float*)(lds + 2 * SHM_V + 2 * SHM_K) + wid * 64; float* li_l = ws, * al_l = ws + 32;
    float m_reg = -1e30f, l_reg = 0; f32x16 o[4] = {};
    const int sr = tid >> 4, sc = (tid & 15) * 8, vst0 = v_st(sr, sc), vst1 = v_st(32 + sr, sc), kws = KSWZ(sr, sc * 2);
    const int vb0 = (int)(uintptr_t)V_lds + v_rd_base(lane);
    const TIn* Kh = cur.K; const TIn* Vh = cur.V;
#define RESC(a) do { if (__any((a) < 1.f)) { if (hi == 0) al_l[r32] = (a); asm volatile("s_waitcnt lgkmcnt(0)" ::: "memory");              \
                     for (int d_ = 0; d_ < 4; ++d_) for (int r = 0; r < 16; ++r) o[d_][r] *= al_l[crow(r, hi)]; } } while (0)
#define KBASE(t) ((j_lo + (t)) * KVBLK)
#define ACT(t) (KBASE(t) <= qlo + QBLK - 1 && KBASE(t) + KVBLK - 1 >= qlo - W + 1)
#define MASKT(P0_, P1_, t) do { const int kb_ = KBASE(t); if ((!SK || ACT(t)) && (kb_ + KVBLK - 1 > qlo || kb_ <= qlo + QBLK - 1 - W)) mask_tile(P0_, P1_, qm - kb_, (unsigned)W); } while (0)
    constexpr int NQL = F32 ? 16 : 8;
    constexpr bool SK = WSKIP && !F32;
#define SEAM_K0() do { VMWN(NQL); if constexpr (F32) { SWRITE_KF(0); SBAR(); SLOAD_F((const float*)nxt.V, kbn); } else { SWRITE_HK(0); } SBAR(); } while (0)
    f32x16 pA0, pA1, pB0, pB1; float mnA, mnB, alA, alB; bf16x8 pa0, pa1, pa2, pa3;
    if constexpr (F32) { VMW(); SWRITE_VF(0); SBAR(); } else { SWRITE_HV(0); SBAR(); }
    if (NT > 1) { if constexpr (F32) SLOAD_F((const float*)Kh, KBASE(1)); else SLOAD_H(Kh, Vh, KBASE(1)); }
    SBAR(); qkt<0, SK>(pA0, pA1, K_lds, r32, hi, S.qr, ACT(0));
    if constexpr (F32) { if (NT > 1) { VMW(); SWRITE_KF(1); SBAR(); SLOAD_F((const float*)Vh, KBASE(1)); } }
    MASKT(pA0, pA1, 0); partialSM(pA0, pA1, m_reg, mnA, alA);
    if (NT > 1) { VMW(); if constexpr (F32) { SWRITE_VF(1); SBAR(); if (NT > 2) SLOAD_F((const float*)Kh, KBASE(2)); } else SWRITE_H(1); }
    __syncthreads();
#define HALF_STEP(PX0, PX1, mnX, alX, PY0, PY1, alY, t, KB, VB, SB) do {                                                      \
        SBAR(); qkt<KB, SK>(PX0, PX1, K_lds, r32, hi, S.qr, ACT(t));                                             \
        finishSM(PY0, PY1, alY, l_reg, pa0, pa1, pa2, pa3); SBAR();                                                           \
        if ((t) + 1 < NT) { if constexpr (F32) { VMW(); SWRITE_KF(SB); SBAR(); SLOAD_F((const float*)Vh, KBASE((t) + 1)); }  \
                            else { SLOAD_H(Kh, Vh, KBASE((t) + 1)); } SBAR(); }                                               \
        pv_tile<VB, SK>(o, vb0, pa0, pa1, pa2, pa3, ACT((t) - 1)); MASKT(PX0, PX1, (t)); partialSM(PX0, PX1, m_reg, mnX, alX);                                        \
        __syncthreads();                                                                                                      \
        if ((t) + 1 < NT) { VMW(); if constexpr (F32) { SWRITE_VF(SB); SBAR(); if ((t) + 2 < NT) SLOAD_F((const float*)Kh, KBASE((t) + 2)); } \
                            else { SWRITE_H(SB); } }                                                                          \
        RESC(alX); __syncthreads(); } while (0)
    for (int t = 1; t + 1 < NT; t += 2) {
        HALF_STEP(pB0, pB1, mnB, alB, pA0, pA1, alA, t, 1, 0, 0);
        HALF_STEP(pA0, pA1, mnA, alA, pB0, pB1, alB, t + 1, 0, 1, 1);
    }
    const bool even = (NT & 1) == 0;
    if (even) { SBAR(); qkt<1, SK>(pB0, pB1, K_lds, r32, hi, S.qr, ACT(NT - 1)); SBAR(); }
#define QROW(e) (nxt.Q + (size_t)(wid * QBLK + r32) * LDR + ((e) >> 1) * 16 + hi * 8 + ((e) & 1) * 4)
    if constexpr (F32) { SLOAD_F((const float*)nxt.K, kbn); SBAR();
#pragma unroll
        for (int e = 0; e < 8; ++e) S.tq[e] = *(const f32x4*)QROW(e); }
    else { SLOAD_H(nxt.K, nxt.V, kbn); SBAR();
#pragma unroll
        for (int d0 = 0; d0 < 8; ++d0) S.qr[d0] = load8<TIn>(nxt.Q + (size_t)(wid * QBLK + r32) * LDR + d0 * 16 + hi * 8); }
    SBAR();
    finishSM(pA0, pA1, alA, l_reg, pa0, pa1, pa2, pa3); SBAR();
    if constexpr (F32) {
#pragma unroll
        for (int e = 8; e < 16; ++e) S.tq[e] = *(const f32x4*)QROW(e); SBAR(); }
#undef QROW
    pv_tile<0, SK>(o, vb0, pa0, pa1, pa2, pa3, ACT(even ? NT - 2 : NT - 1));
    if (even) { MASKT(pB0, pB1, NT - 1); partialSM(pB0, pB1, m_reg, mnB, alB); __syncthreads(); RESC(alB);
        finishSM(pB0, pB1, alB, l_reg, pa0, pa1, pa2, pa3); SBAR(); pv_tile<1, SK>(o, vb0, pa0, pa1, pa2, pa3, ACT(NT - 1)); }
    SBAR(); SEAM_K0();
    if (hi == 0) li_l[r32] = l_reg; asm volatile("s_waitcnt lgkmcnt(0)" ::: "memory");
    float rli[16];
#pragma unroll
    for (int r = 0; r < 16; ++r) rli[r] = __builtin_amdgcn_rcpf(li_l[crow(r, hi)]);
    TOut* Ow = cur.O + (size_t)(wid * QBLK) * LDR;
    if constexpr (same_t<TOut, float>::v) {
#pragma unroll
        for (int r = 0; r < 16; ++r) { const int orow = crow(r, hi);
#pragma unroll
            for (int d0 = 0; d0 < 4; ++d0) Ow[(size_t)orow * LDR + d0 * 32 + r32] = o[d0][r] * rli[r]; }
    } else {
        unsigned short* stg = (unsigned short*)(lds + LDS_BYTES) + wid * 4096;
        int hi_e = hi, r32_e = r32, lane_e = lane; asm volatile("" : "+v"(hi_e), "+v"(r32_e), "+v"(lane_e));
#pragma unroll
        for (int r = 0; r < 16; ++r) { const int orow = crow(r, hi_e);
#pragma unroll
            for (int d0 = 0; d0 < 4; ++d0) stg[orow * 128 + d0 * 32 + r32_e] = (unsigned short)cvtpk(o[d0][r] * rli[r], 0.f); }
        asm volatile("s_waitcnt lgkmcnt(0)" ::: "memory");
#pragma unroll
        for (int i = 0; i < 8; ++i) { const int row = i * 4 + (lane_e >> 4), ch = lane_e & 15; const u32x4 v = *(const u32x4*)(stg + row * 128 + ch * 8); *(u32x4*)(Ow + (unsigned)(row * LDR + ch * 8)) = v; }
    }
    if constexpr (F32) {
#pragma unroll
        for (int d0 = 0; d0 < 8; ++d0) S.qr[d0] = pack8(S.tq[2 * d0], S.tq[2 * d0 + 1]); }
    __syncthreads();
#undef RESC
#undef KBASE
#undef ACT
#undef MASKT
#undef SEAM_K0
#undef HALF_STEP
}
#undef ROW
#undef VMW
#undef VMWN
#undef SLOAD_H
#undef SWRITE_HK
#undef SWRITE_HV
#undef SWRITE_H
#undef SLOAD_F
#undef SWRITE_KF
#undef SWRITE_VF

}
namespace pg8 {
template <class F> struct EpiAdapt {
    static constexpr bool PERM = true, AFTER_DRAIN = false; F f;
    __device__ __forceinline__ void operator()(const f32x4 (&acc)[2][2][4][2], const Unit& u, int wr, int wc, int fr, int fq) const {
        const int c = wc * 32 + fq * 8;
#pragma unroll
        for (int ai = 0; ai < 2; ++ai)
#pragma unroll
            for (int m = 0; m < 4; ++m) {
                const int row = u.pm * BM + ai * HALF + wr * 64 + m * 16 + fr;
                float lo[8], hi[8];
#pragma unroll
                for (int j = 0; j < 4; ++j) { lo[j] = acc[ai][0][m][0][j]; lo[4 + j] = acc[ai][0][m][1][j]; hi[j] = acc[ai][1][m][0][j]; hi[4 + j] = acc[ai][1][m][1][j]; }
                f(row, u.pn, c, lo, hi);
            }
    }
};
}

typedef unsigned short bf16_t;
typedef short bf16x8 __attribute__((ext_vector_type(8)));
typedef float f32x4 __attribute__((ext_vector_type(4)));
typedef unsigned u32x4 __attribute__((ext_vector_type(4)));
#define LAS __attribute__((address_space(3)))

constexpr int D = 2048, NB = 4, S = 4096, M = NB * S, NIN = 7168, DFF = 5632, NGU = 2 * DFF;
constexpr float LN_EPS = 1e-5f, RMS_EPS = 1e-6f;
constexpr float ALPHA = 1.189207115002721f;
constexpr float LAMBDA_INIT = 0.2f;
constexpr float LOG2E = 1.4426950408889634f;
constexpr float QSCALE = 0.08838834764831845f;
constexpr int NWAVES = 8, NTHREADS = 512;
constexpr int LDS_BYTES = 147456;

constexpr size_t MiB = 1u << 20;
constexpr size_t OFF_BAR = 0;
constexpr size_t OFF_MOD = 64 * 1024, OFF_LB = 320 * 1024, OFF_LAM = 328 * 1024;
constexpr size_t OFF_COS = 1 * MiB, OFF_SIN = 5 * MiB;
constexpr size_t OFF_WIN = 16 * MiB, OFF_WO = 44 * MiB, OFF_WGU = 52 * MiB, OFF_WD = 96 * MiB;
constexpr size_t OFF_U = 120 * MiB, OFF_MIX = 184 * MiB;
constexpr size_t OFF_QH = 248 * MiB, OFF_VH = 280 * MiB, OFF_GH = 312 * MiB, OFF_LOGF = 344 * MiB, OFF_QA = 408 * MiB, OFF_KA = 440 * MiB, OFF_VA = 472 * MiB;
constexpr size_t OFF_T1 = 248 * MiB, OFF_H1 = 376 * MiB, OFF_HFF = 184 * MiB;
constexpr size_t OFF_O1 = 120 * MiB, OFF_O2 = 152 * MiB;
constexpr size_t WS_NEED = 504 * MiB;

__device__ __forceinline__ float bf2f(bf16_t v) { return __uint_as_float((unsigned)v << 16); }
__device__ __forceinline__ bf16_t f2bf(float f) { unsigned u = __float_as_uint(f); return (bf16_t)((u + 0x7fffu + ((u >> 16) & 1u)) >> 16); }
__device__ __forceinline__ unsigned pk2(float lo, float hi) { return (unsigned)f2bf(lo) | ((unsigned)f2bf(hi) << 16); }
__device__ __forceinline__ float sigmoidf_(float x) { return 1.f / (1.f + __expf(-x)); }
__device__ __forceinline__ float wave_sum(float v) {
#pragma unroll
    for (int o = 1; o < 64; o <<= 1) v += __shfl_xor(v, o);
    return v;
}

struct Ptrs {
    const float *x, *c; const int* positions; const float *w_ada, *b_ada, *w_in, *lb_logits, *hg_norm_w, *lq1, *lk1, *lq2, *lk2, *subln_w, *w_out, *ln1_g, *ln1_b, *w_gate, *w_up, *w_down, *ln2_g, *ln2_b;
    float* out; float *mod, *lbv, *lam, *cosT, *sinT; bf16_t *WinT, *WoT, *WguT, *WdT, *U, *MIX, *Qh, *Vh, *Gh, *Qa, *Ka, *Va, *Hff, *O1, *O2; float *Logf, *T1, *H1;
};

struct Epi1 {
    bf16_t *Qh, *Vh, *Gh, *Qa, *Ka, *Va; float* Logf; const float *lbv, *cosT, *sinT;
    __device__ __forceinline__ void operator()(int row, int pn, int c, const float (&lo)[8], const float (&hi)[8]) const {
        const int seg = pn >> 2, pt = pn & 3;
        if (seg == 4 || seg == 5) {
            const int head = 2 * pt + (c >> 6), d0 = c & 63; const float sc = (seg == 4) ? QSCALE * LOG2E : 1.f;
            const f32x4 c0 = *(const f32x4*)(cosT + (size_t)row * 64 + d0), c1 = *(const f32x4*)(cosT + (size_t)row * 64 + d0 + 4);
            const f32x4 s0 = *(const f32x4*)(sinT + (size_t)row * 64 + d0), s1 = *(const f32x4*)(sinT + (size_t)row * 64 + d0 + 4);
            float o1[8], o2[8];
#pragma unroll
            for (int j = 0; j < 8; ++j) { const float cs = j < 4 ? c0[j & 3] : c1[j & 3], sn = j < 4 ? s0[j & 3] : s1[j & 3];
                o1[j] = (lo[j] * cs - hi[j] * sn) * sc; o2[j] = (hi[j] * cs + lo[j] * sn) * sc; }
            bf16_t* dst = (seg == 4 ? Qa : Ka) + (size_t)row * 1024 + head * 128 + d0;
            u32x4 w1 = {pk2(o1[0], o1[1]), pk2(o1[2], o1[3]), pk2(o1[4], o1[5]), pk2(o1[6], o1[7])}, w2 = {pk2(o2[0], o2[1]), pk2(o2[2], o2[3]), pk2(o2[4], o2[5]), pk2(o2[6], o2[7])};
            *(u32x4*)dst = w1; *(u32x4*)(dst + 64) = w2;
            return;
        }
#pragma unroll
        for (int h = 0; h < 2; ++h) {
            const int col = 256 * pt + 128 * h + c; float v[8];
#pragma unroll
            for (int j = 0; j < 8; ++j) v[j] = h ? hi[j] : lo[j];
            if (seg == 1) {
                float* dst = Logf + (size_t)row * 1024 + col;
                const f32x4 l0 = *(const f32x4*)(lbv + col), l1 = *(const f32x4*)(lbv + col + 4);
                f32x4 r0, r1;
#pragma unroll
                for (int j = 0; j < 8; ++j) { const float lb = j < 4 ? l0[j & 3] : l1[j & 3]; const float f = lb + (1.f - lb) * sigmoidf_(v[j]); if (j < 4) r0[j & 3] = __log2f(f); else r1[j & 3] = __log2f(f); }
                *(f32x4*)dst = r0; *(f32x4*)(dst + 4) = r1;
            } else {
                if (seg == 0) {
#pragma unroll
                    for (int j = 0; j < 8; ++j) v[j] = v[j] * sigmoidf_(v[j]) * QSCALE;
                } else if (seg == 3) {
#pragma unroll
                    for (int j = 0; j < 8; ++j) v[j] = sigmoidf_(v[j]);
                }
                bf16_t* dst = (seg == 0 ? Qh : seg == 2 ? Vh : seg == 3 ? Gh : Va) + (size_t)row * 1024 + col;
                u32x4 w = {pk2(v[0], v[1]), pk2(v[2], v[3]), pk2(v[4], v[5]), pk2(v[6], v[7])};
                *(u32x4*)dst = w;
            }
        }
    }
};
struct EpiRes {
    const float* res; const float* gate; float* out;
    __device__ __forceinline__ void operator()(int row, int pn, int c, const float (&lo)[8], const float (&hi)[8]) const {
        const int b = row / S;
#pragma unroll
        for (int h = 0; h < 2; ++h) { const size_t col = 256 * pn + 128 * h + c; const size_t o = (size_t)row * D + col;
            const f32x4 r0 = *(const f32x4*)(res + o), r1 = *(const f32x4*)(res + o + 4), g0 = *(const f32x4*)(gate + (size_t)b * 6 * D + col), g1 = *(const f32x4*)(gate + (size_t)b * 6 * D + col + 4);
            f32x4 v0, v1;
#pragma unroll
            for (int j = 0; j < 4; ++j) { v0[j] = h ? hi[j] : lo[j]; v1[j] = h ? hi[4 + j] : lo[4 + j]; }
            *(f32x4*)(out + o) = r0 * ALPHA + g0 * v0; *(f32x4*)(out + o + 4) = r1 * ALPHA + g1 * v1; }
    }
};
struct EpiSwiglu {
    bf16_t* Hff;
    __device__ __forceinline__ void operator()(int row, int pn, int c, const float (&lo)[8], const float (&hi)[8]) const {
        float v[8];
#pragma unroll
        for (int j = 0; j < 8; ++j) v[j] = lo[j] * sigmoidf_(lo[j]) * hi[j];
        u32x4 w = {pk2(v[0], v[1]), pk2(v[2], v[3]), pk2(v[4], v[5]), pk2(v[6], v[7])};
        *(u32x4*)(Hff + (size_t)row * DFF + 128 * pn + c) = w;
    }
};

__device__ __forceinline__ int src_col_win(int n) {
    const int pn = n >> 8, t = n & 255, seg = pn >> 2, pt = pn & 3;
    if (seg == 4 || seg == 5) { const int bj = t >> 7, o = t & 127; return seg * 1024 + (2 * pt + (o >> 6)) * 128 + (o & 63) + 64 * bj; }
    return n;
}
__device__ __forceinline__ void transpose_item(const float* Wsrc, int ldw, bf16_t* WTrow, int K, int k0, LAS float* scr, int lane) {
#pragma unroll 8
    for (int i = 0; i < 32; ++i) { const int kk = 2 * i + (lane >> 5); scr[kk * 33 + (lane & 31)] = Wsrc[(size_t)(k0 + kk) * ldw + (lane & 31)]; }
    asm volatile("s_waitcnt lgkmcnt(0)" ::: "memory");
    const int c = lane & 7;
#pragma unroll
    for (int j = 0; j < 4; ++j) { const int n = (lane >> 3) + 8 * j; const LAS float* s = scr + (8 * c) * 33 + n;
        u32x4 o; o.x = pk2(s[0 * 33], s[1 * 33]); o.y = pk2(s[2 * 33], s[3 * 33]); o.z = pk2(s[4 * 33], s[5 * 33]); o.w = pk2(s[6 * 33], s[7 * 33]);
        *(u32x4*)(WTrow + (size_t)n * K + k0 + 8 * c) = o; }
    asm volatile("s_waitcnt lgkmcnt(0)" ::: "memory");
}
__device__ __forceinline__ void p0_prologue(const Ptrs& P, LAS unsigned char* lds, int tid, int lane, int wave) {
    {
        LAS float* cond = (LAS float*)lds;
        LAS float* part = (LAS float*)(lds + 32768);
        for (int i = tid; i < NB * D; i += NTHREADS) { const float v = P.c[i]; cond[i] = v / (1.f + __expf(-v)); }
        __syncthreads();
        for (int chunk = blockIdx.x; chunk < 6 * D / 48; chunk += gridDim.x) {
            const int col = tid % 48, ks = tid / 48, e = chunk * 48 + col;
            if (tid < 480) {
                float a0 = 0, a1 = 0, a2 = 0, a3 = 0;
#pragma unroll 8
                for (int k = ks; k < D; k += 10) { const float w = P.w_ada[(size_t)k * (6 * D) + e]; a0 += cond[k] * w; a1 += cond[D + k] * w; a2 += cond[2 * D + k] * w; a3 += cond[3 * D + k] * w; }
                LAS float* pp = part + (ks * 48 + col) * 4; pp[0] = a0; pp[1] = a1; pp[2] = a2; pp[3] = a3;
            }
            __syncthreads();
            if (tid < 192) { const int cc = tid % 48, b = tid / 48; float s = P.b_ada[chunk * 48 + cc];
#pragma unroll
                for (int q = 0; q < 10; ++q) s += part[(q * 48 + cc) * 4 + b];
                P.mod[(size_t)b * 6 * D + chunk * 48 + cc] = s; }
            __syncthreads();
        }
    }
    for (int gid = blockIdx.x * NTHREADS + tid; gid < M * 64; gid += gridDim.x * NTHREADS) {
        const int row = gid >> 6, i = gid & 63;
        const double inv = exp2(-(double)i * (13.287712379549449 / 64.0));
        const double rev = (double)P.positions[row] * inv * 0.15915494309189535;
        const float fr = (float)(rev - rint(rev));
        P.cosT[gid] = __builtin_amdgcn_cosf(fr); P.sinT[gid] = __builtin_amdgcn_sinf(fr);
    }
    if (blockIdx.x == 0) {
        for (int i = tid; i < 1024; i += NTHREADS) P.lbv[i] = 1.f / (1.f + __expf(P.lb_logits[1024 + i] - P.lb_logits[i]));
        if (tid == 0) { float s1 = 0, s2 = 0; for (int i = 0; i < 128; ++i) { s1 += P.lq1[i] * P.lk1[i]; s2 += P.lq2[i] * P.lk2[i]; } P.lam[0] = expf(s1) - expf(s2) + LAMBDA_INIT; }
    }
    {
        LAS float* scr = (LAS float*)(lds + wave * 16384);
        const int gw = blockIdx.x * NWAVES + wave, NGW = gridDim.x * NWAVES;
        constexpr int I_IN = (D / 64) * (NIN / 32), I_O = (D / 64) * (D / 32), I_GU = (D / 64) * (NGU / 32), I_D = (DFF / 64) * (D / 32);
        for (int it = gw; it < I_IN + I_O + I_GU + I_D; it += NGW) {
            int r = it;
            if (r < I_IN) { const int nb = r % (NIN / 32), kb = r / (NIN / 32), n0 = nb * 32; transpose_item(P.w_in + src_col_win(n0), NIN, P.WinT + (size_t)n0 * D, D, kb * 64, scr, lane); continue; } r -= I_IN;
            if (r < I_O) { const int nb = r % (D / 32), kb = r / (D / 32), n0 = nb * 32; transpose_item(P.w_out + n0, D, P.WoT + (size_t)n0 * D, D, kb * 64, scr, lane); continue; } r -= I_O;
            if (r < I_GU) { const int nb = r % (NGU / 32), kb = r / (NGU / 32), n0 = nb * 32, pn = n0 >> 8, t = n0 & 255;
                const float* src = (t < 128) ? P.w_gate + 128 * pn + t : P.w_up + 128 * pn + (t - 128);
                transpose_item(src, DFF, P.WguT + (size_t)n0 * D, D, kb * 64, scr, lane); continue; } r -= I_GU;
            { const int nb = r % (D / 32), kb = r / (D / 32), n0 = nb * 32; transpose_item(P.w_down + n0, D, P.WdT + (size_t)n0 * DFF, DFF, kb * 64, scr, lane); }
        }
    }
}

__device__ __forceinline__ void ln_stats(const f32x4 (&v)[8], float& mean, float& rstd) {
    float s = 0;
#pragma unroll
    for (int j = 0; j < 8; ++j) s += (v[j][0] + v[j][1]) + (v[j][2] + v[j][3]);
    mean = wave_sum(s) * (1.f / D); float q = 0;
#pragma unroll
    for (int j = 0; j < 8; ++j) { const f32x4 d = v[j] - mean; q += (d[0] * d[0] + d[1] * d[1]) + (d[2] * d[2] + d[3] * d[3]); }
    rstd = rsqrtf(wave_sum(q) * (1.f / D) + LN_EPS);
}
__device__ __forceinline__ void mod_store_bf16(const f32x4 (&v)[8], float mean, float rstd, const float* sc, const float* sh, bf16_t* dst, int lane) {
#pragma unroll
    for (int j = 0; j < 8; ++j) { const int col = 4 * lane + 256 * j; const f32x4 o = (v[j] - mean) * rstd * (*(const f32x4*)(sc + col) + 1.f) + *(const f32x4*)(sh + col);
        uint2 w; w.x = pk2(o[0], o[1]); w.y = pk2(o[2], o[3]); *(uint2*)(dst + col) = w; }
}
__device__ __forceinline__ void p1_ln_mod(const Ptrs& P, int lane, int wave) {
    for (int row = blockIdx.x * NWAVES + wave; row < M; row += gridDim.x * NWAVES) {
        const f32x4* xr = (const f32x4*)(P.x + (size_t)row * D) + lane; f32x4 v[8];
#pragma unroll
        for (int j = 0; j < 8; ++j) v[j] = xr[64 * j];
        float mean, rstd; ln_stats(v, mean, rstd);
        const float* mb = P.mod + (size_t)(row / S) * 6 * D;
        mod_store_bf16(v, mean, rstd, mb + D, mb, P.U + (size_t)row * D, lane);
    }
}
__device__ __forceinline__ void p5_ln1(const Ptrs& P, int lane, int wave) {
    for (int row = blockIdx.x * NWAVES + wave; row < M; row += gridDim.x * NWAVES) {
        const f32x4* xr = (const f32x4*)(P.T1 + (size_t)row * D) + lane; f32x4 v[8];
#pragma unroll
        for (int j = 0; j < 8; ++j) v[j] = xr[64 * j];
        float mean, rstd; ln_stats(v, mean, rstd);
#pragma unroll
        for (int j = 0; j < 8; ++j) { const int col = 4 * lane + 256 * j; v[j] = (v[j] - mean) * rstd * *(const f32x4*)(P.ln1_g + col) + *(const f32x4*)(P.ln1_b + col);
            *(f32x4*)(P.H1 + (size_t)row * D + col) = v[j]; }
        ln_stats(v, mean, rstd);
        const float* mb = P.mod + (size_t)(row / S) * 6 * D;
        mod_store_bf16(v, mean, rstd, mb + 4 * D, mb + 3 * D, P.U + (size_t)row * D, lane);
    }
}
__device__ __forceinline__ void p8_ln_final(const Ptrs& P, int lane, int wave) {
    for (int row = blockIdx.x * NWAVES + wave; row < M; row += gridDim.x * NWAVES) {
        f32x4* xr = (f32x4*)(P.out + (size_t)row * D) + lane; f32x4 v[8];
#pragma unroll
        for (int j = 0; j < 8; ++j) v[j] = xr[64 * j];
        float mean, rstd; ln_stats(v, mean, rstd);
#pragma unroll
        for (int j = 0; j < 8; ++j) { const int col = 4 * lane + 256 * j; xr[64 * j] = (v[j] - mean) * rstd * *(const f32x4*)(P.ln2_g + col) + *(const f32x4*)(P.ln2_b + col); }
    }
}

__device__ __forceinline__ void hgrn_simple_item(const Ptrs& P, int item, unsigned char* lds, int tid) {
    float* sf = (float*)lds; float* sk = sf + 128; float* sq = sk + 128; float* po = sq + 128  ; float* red = po + 512;
    const int b = item >> 3, h = item & 7, v = tid & 127, qd = tid >> 7;
    float St[32];
#pragma unroll
    for (int d = 0; d < 32; ++d) St[d] = 0.f;
    const float w = P.hg_norm_w[v];
    for (int t = 0; t < S; ++t) {
        const size_t off = (size_t)(b * S + t) * 1024 + h * 128 + v;
        if (qd == 0) { const float f = exp2f(P.Logf[off]); sf[v] = f; sk[v] = 1.f - f; sq[v] = bf2f(P.Qh[off]); }
        const float vv = bf2f(P.Vh[off]);
        __syncthreads();
        float o = 0.f;
#pragma unroll
        for (int d = 0; d < 32; ++d) { const int dd = qd * 32 + d; St[d] = sf[dd] * St[d] + sk[dd] * vv; o += St[d] * sq[dd]; }
        po[qd * 128 + v] = o;
        __syncthreads();
        if (qd == 0) { o = (po[v] + po[128 + v]) + (po[256 + v] + po[384 + v]); const float ss = wave_sum(o * o); if ((tid & 63) == 0) red[tid >> 6] = ss; }
        __syncthreads();
        if (qd == 0) { const float tot = red[0] + red[1]; const float gg = bf2f(P.Gh[off]);
            P.MIX[(size_t)(b * S + t) * D + h * 128 + v] = f2bf(o * rsqrtf(tot * (1.f / 128.f) + RMS_EPS) * w * gg); }
    }
    __syncthreads();
}
typedef attn::BlockRef<attn::bf16, attn::bf16> ARef;
__device__ __forceinline__ ARef attn_ref(const Ptrs& P, int L, int pass) {
    const int x = L & 7, k = (L >> 3) & 31, rd = L >> 8, g = x * 4 + rd * 2 + (k >> 4), b = g >> 3, hh = g & 7, idx = k & 15, vh = idx & 1, pair = idx >> 1;
    const int qb = pass ? 15 - pair : pair;
    ARef r; const size_t row0 = (size_t)b * S + (size_t)qb * 256;
    r.Q = (const attn::bf16*)P.Qa + row0 * 1024 + hh * 128;
    r.K = (const attn::bf16*)P.Ka + (size_t)b * S * 1024 + hh * 128;
    r.V = (const attn::bf16*)P.Va + (size_t)b * S * 1024 + (hh >> 1) * 256 + vh * 128;
    r.O = (attn::bf16*)((hh & 1) ? P.O2 : P.O1) + row0 * 1024 + (hh >> 1) * 256 + vh * 128;
    r.P0 = qb * 256;
    return r;
}
__device__ __forceinline__ void p3_attention(const Ptrs& P, unsigned char* lds, const int tid) {
    const int G = gridDim.x, bid = blockIdx.x;
    if (bid >= 512) return;
    const int nblk = 2 * ((512 - bid + G - 1) / G);
    ARef cur = attn_ref(P, bid, 0);
    attn::Seam<attn::bf16> Sm;
    attn::causal_swa_prime<attn::bf16, attn::bf16>(cur, S, (char*)lds, Sm, tid);
    for (int q = 0; q < nblk; ++q) {
        const bool last = (q + 1 == nblk);
        const ARef nxt = last ? cur : attn_ref(P, bid + ((q + 1) >> 1) * G, (q + 1) & 1);
        attn::causal_swa_block<attn::bf16, attn::bf16>(cur, nxt, S, S, (char*)lds, Sm, tid);
        cur = nxt;
    }
}
__device__ __forceinline__ void p4_attn_combine(const Ptrs& P, int lane, int wave) {
    const float lam = P.lam[0];
    const f32x4 w = *(const f32x4*)(P.subln_w + 4 * lane);
    for (int row = blockIdx.x * NWAVES + wave; row < M; row += gridDim.x * NWAVES) {
#pragma unroll
        for (int h = 0; h < 4; ++h) {
            const uint2 a = *(const uint2*)(P.O1 + (size_t)row * 1024 + h * 256 + 4 * lane), b2 = *(const uint2*)(P.O2 + (size_t)row * 1024 + h * 256 + 4 * lane);
            float y[4];
            y[0] = __uint_as_float(a.x << 16) - lam * __uint_as_float(b2.x << 16); y[1] = __uint_as_float(a.x & 0xffff0000u) - lam * __uint_as_float(b2.x & 0xffff0000u);
            y[2] = __uint_as_float(a.y << 16) - lam * __uint_as_float(b2.y << 16); y[3] = __uint_as_float(a.y & 0xffff0000u) - lam * __uint_as_float(b2.y & 0xffff0000u);
            const float ss = wave_sum((y[0] * y[0] + y[1] * y[1]) + (y[2] * y[2] + y[3] * y[3]));
            const float rs = rsqrtf(ss * (1.f / 256.f) + RMS_EPS) * (1.f - LAMBDA_INIT);
            uint2 o; o.x = pk2(y[0] * rs * w[0], y[1] * rs * w[1]); o.y = pk2(y[2] * rs * w[2], y[3] * rs * w[3]);
            *(uint2*)(P.MIX + (size_t)row * D + 1024 + h * 256 + 4 * lane) = o;
        }
    }
}
__device__ __forceinline__ void p3_mixers(const Ptrs& P, unsigned char* lds, int tid) {
    p3_attention(P, lds, tid);
    for (int it = blockIdx.x; it < 32; it += gridDim.x) hgrn_simple_item(P, it, lds, tid);
}


#define XB_TMO      128
#define XB_XCNT(j)  (256  + 64 * (j))
#define XB_XSUB(j)  (1280 + 64 * (j))
#define XB_XGEN(j)  (2304 + 64 * (j))
#define XB_TOP      3328
#define XB_TOPGEN   3392
#define XCD_BAR_WORDS 3456
#define XB_SPIN_CAP (1u << 18)
__device__ __forceinline__ unsigned xb_ld(unsigned* p)              { return __hip_atomic_load(p, __ATOMIC_RELAXED, __HIP_MEMORY_SCOPE_AGENT); }
__device__ __forceinline__ unsigned xb_add(unsigned* p, unsigned v) { return __hip_atomic_fetch_add(p, v, __ATOMIC_RELAXED, __HIP_MEMORY_SCOPE_AGENT); }
__device__ __forceinline__ unsigned xb_xcc_id() { return (unsigned)__builtin_amdgcn_s_getreg((3 << 11) | 20) & 0xFu; }
#define XB_SPIN(cond, bar) do { unsigned _sp = 0; while (cond) { __builtin_amdgcn_s_sleep(1); \
    if ((++_sp & 255u) == 0u) { if (xb_ld(&(bar)[XB_TMO])) break; if (_sp > XB_SPIN_CAP) { atomicAdd(&(bar)[XB_TMO], 1u); break; } } } } while (0)
__device__ __forceinline__ void xcd_barrier_post(unsigned* bar, int tid) { if (tid == 0) (void)xb_add(&bar[XB_XCNT(xb_xcc_id())], 1u); }
__device__ __forceinline__ void xcd_barrier_complete(unsigned* bar, unsigned x, unsigned& nloc, unsigned& nx) {
    const unsigned G = gridDim.x * gridDim.y * gridDim.z;
    unsigned sum, cnt, mine, sp = 0u;
    for (;;) {
        sum = 0u; cnt = 0u; mine = 0u;
#pragma unroll
        for (unsigned j = 0; j < 16; ++j) { const unsigned c = xb_ld(&bar[XB_XCNT(j)]); sum += c; cnt += (c > 0u) ? 1u : 0u; mine = (j == x) ? c : mine; }
        if (sum == G) break;
        __builtin_amdgcn_s_sleep(1);
        if ((++sp & 255u) == 0u) { if (xb_ld(&bar[XB_TMO])) break; if (sp > XB_SPIN_CAP) { atomicAdd(&bar[XB_TMO], 1u); break; } }
    }
    nloc = mine > 0u ? mine : 1u; nx = cnt > 0u ? cnt : 1u;
}
__device__ __forceinline__ void xcd_barrier(unsigned* bar, volatile LAS unsigned* st, int tid) {
    asm volatile("s_waitcnt vmcnt(0)" ::: "memory");
    __syncthreads();
    if (tid == 0) {
        const unsigned x = xb_xcc_id();
        __builtin_amdgcn_s_waitcnt(0);
        unsigned nloc = st[0], nx = st[1];
        if (nloc == 0u) { xcd_barrier_complete(bar, x, nloc, nx); st[0] = nloc; st[1] = nx; }
        const unsigned old = xb_add(&bar[XB_XSUB(x)], 1u);
        const unsigned gen = old / nloc;
        if (old + 1u == (gen + 1u) * nloc) {
            __builtin_amdgcn_fence(__ATOMIC_RELEASE, "agent");
            asm volatile("s_waitcnt vmcnt(0)" ::: "memory");
            const unsigned og = xb_add(&bar[XB_TOP], 1u);
            const unsigned tg = og / nx;
            if (og + 1u == (tg + 1u) * nx) xb_add(&bar[XB_TOPGEN], 1u);
            else XB_SPIN(xb_ld(&bar[XB_TOPGEN]) == tg, bar);
            __builtin_amdgcn_fence(__ATOMIC_ACQUIRE, "agent");
            xb_add(&bar[XB_XGEN(x)], 1u);
            asm volatile("s_waitcnt vmcnt(0)" ::: "memory");
        } else {
            XB_SPIN(xb_ld(&bar[XB_XGEN(x)]) == gen, bar);
            __builtin_amdgcn_fence(__ATOMIC_ACQUIRE, "agent");
            asm volatile("s_waitcnt vmcnt(0)" ::: "memory");
        }
    }
    __syncthreads();
}

__device__ __forceinline__ int lane_id_asm() { int l; asm volatile("v_mbcnt_lo_u32_b32 %0, -1, 0\n\tv_mbcnt_hi_u32_b32 %0, -1, %0" : "=v"(l)); return l; }
struct Args { const void* in[21]; float* out; unsigned char* ws; int ph_lo, ph_hi; };
constexpr int NPHASE = 10;
__device__ __forceinline__ Ptrs mk_ptrs(const Args& a) {
    Ptrs P;
    P.x = (const float*)a.in[0]; P.c = (const float*)a.in[1]; P.positions = (const int*)a.in[2]; P.w_ada = (const float*)a.in[3]; P.b_ada = (const float*)a.in[4]; P.w_in = (const float*)a.in[5];
    P.lb_logits = (const float*)a.in[6]; P.hg_norm_w = (const float*)a.in[7]; P.lq1 = (const float*)a.in[8]; P.lk1 = (const float*)a.in[9]; P.lq2 = (const float*)a.in[10]; P.lk2 = (const float*)a.in[11];
    P.subln_w = (const float*)a.in[12]; P.w_out = (const float*)a.in[13]; P.ln1_g = (const float*)a.in[14]; P.ln1_b = (const float*)a.in[15]; P.w_gate = (const float*)a.in[16]; P.w_up = (const float*)a.in[17];
    P.w_down = (const float*)a.in[18]; P.ln2_g = (const float*)a.in[19]; P.ln2_b = (const float*)a.in[20];
    P.out = a.out; unsigned char* ws = a.ws;
    P.mod = (float*)(ws + OFF_MOD); P.lbv = (float*)(ws + OFF_LB); P.lam = (float*)(ws + OFF_LAM); P.cosT = (float*)(ws + OFF_COS); P.sinT = (float*)(ws + OFF_SIN);
    P.WinT = (bf16_t*)(ws + OFF_WIN); P.WoT = (bf16_t*)(ws + OFF_WO); P.WguT = (bf16_t*)(ws + OFF_WGU); P.WdT = (bf16_t*)(ws + OFF_WD);
    P.U = (bf16_t*)(ws + OFF_U); P.MIX = (bf16_t*)(ws + OFF_MIX); P.Qh = (bf16_t*)(ws + OFF_QH); P.Vh = (bf16_t*)(ws + OFF_VH); P.Gh = (bf16_t*)(ws + OFF_GH); P.Logf = (float*)(ws + OFF_LOGF);
    P.Qa = (bf16_t*)(ws + OFF_QA); P.Ka = (bf16_t*)(ws + OFF_KA); P.Va = (bf16_t*)(ws + OFF_VA); P.T1 = (float*)(ws + OFF_T1); P.H1 = (float*)(ws + OFF_H1); P.Hff = (bf16_t*)(ws + OFF_HFF); P.O1 = (bf16_t*)(ws + OFF_O1); P.O2 = (bf16_t*)(ws + OFF_O2);
    return P;
}
__global__ void __launch_bounds__(NTHREADS, 2) fwd_kernel(Args a) {
    extern __shared__ __attribute__((aligned(16))) unsigned char lds[];
    cg::grid_group grid = cg::this_grid();
    const int wave = __builtin_amdgcn_readfirstlane(threadIdx.x >> 6);
    LAS unsigned char* ldsl = (LAS unsigned char*)lds;
    volatile LAS unsigned* bst = (volatile LAS unsigned*)(ldsl + LDS_BYTES - 64);
    { const int l0 = lane_id_asm(); if (wave == 0 && l0 < 2) bst[l0] = 0u; }
    __syncthreads();
    const int lo = a.ph_lo, hi = a.ph_hi;
#define IN(k) (lo <= (k) && (k) < hi)
#define SEAM(k) do { if (IN(k) && IN((k) + 1)) { const int lane_ = lane_id_asm(); xcd_barrier((unsigned*)(a.ws + OFF_BAR), bst, wave * 64 + lane_); } } while (0)
    if (IN(0) && blockIdx.x == 0) { const int lane_ = lane_id_asm(); unsigned* bw = (unsigned*)(a.ws + OFF_BAR); for (int i = wave * 64 + lane_; i < XCD_BAR_WORDS; i += NTHREADS) bw[i] = 0u; }
    if (IN(0)) { const Ptrs P = mk_ptrs(a); const int lane = lane_id_asm(), tid = wave * 64 + lane; p0_prologue(P, ldsl, tid, lane, wave); }
    if (IN(0) && IN(1)) { grid.sync(); { const int lane_ = lane_id_asm(); xcd_barrier_post((unsigned*)(a.ws + OFF_BAR), wave * 64 + lane_); } }
    if (IN(1)) { const Ptrs P = mk_ptrs(a); const int lane = lane_id_asm(), tid = wave * 64 + lane; p1_ln_mod(P, lane, wave); } SEAM(1);
    if (IN(2)) { const Ptrs P = mk_ptrs(a); const int lane = lane_id_asm(), tid = wave * 64 + lane;
        pg8::Gemm g{P.U, P.WinT, M, NIN, D}; pg8::StaticOrder So; So.init(M, NIN, gridDim.x, blockIdx.x);
        pg8::EpiAdapt<Epi1> E{Epi1{P.Qh, P.Vh, P.Gh, P.Qa, P.Ka, P.Va, P.Logf, P.lbv, P.cosT, P.sinT}};
        pg8::gemm_phase<pg8::EpiAdapt<Epi1>, pg8::StaticOrder, true, true>(ldsl, g, So, E, tid);
    } SEAM(2);
    if (IN(3)) { const Ptrs P = mk_ptrs(a); const int lane = lane_id_asm(), tid = wave * 64 + lane; p3_mixers(P, lds, tid); } SEAM(3);
    if (IN(4)) { const Ptrs P = mk_ptrs(a); const int lane = lane_id_asm(), tid = wave * 64 + lane; p4_attn_combine(P, lane, wave); } SEAM(4);
    if (IN(5)) { const Ptrs P = mk_ptrs(a); const int lane = lane_id_asm(), tid = wave * 64 + lane;
        pg8::Gemm g{P.MIX, P.WoT, M, D, D}; pg8::StaticOrder So; So.init(M, D, gridDim.x, blockIdx.x);
        pg8::EpiAdapt<EpiRes> E{EpiRes{P.x, P.mod + 2 * D, P.T1}};
        pg8::gemm_phase<pg8::EpiAdapt<EpiRes>, pg8::StaticOrder, true, true>(ldsl, g, So, E, tid);
    } SEAM(5);
    if (IN(6)) { const Ptrs P = mk_ptrs(a); const int lane = lane_id_asm(), tid = wave * 64 + lane; p5_ln1(P, lane, wave); } SEAM(6);
    if (IN(7)) { const Ptrs P = mk_ptrs(a); const int lane = lane_id_asm(), tid = wave * 64 + lane;
        pg8::Gemm g{P.U, P.WguT, M, NGU, D}; pg8::StaticOrder So; So.init(M, NGU, gridDim.x, blockIdx.x);
        pg8::EpiAdapt<EpiSwiglu> E{EpiSwiglu{P.Hff}};
        pg8::gemm_phase<pg8::EpiAdapt<EpiSwiglu>, pg8::StaticOrder, true, true>(ldsl, g, So, E, tid);
    } SEAM(7);
    if (IN(8)) { const Ptrs P = mk_ptrs(a); const int lane = lane_id_asm(), tid = wave * 64 + lane;
        pg8::Gemm g{P.Hff, P.WdT, M, D, DFF}; pg8::StaticOrder So; So.init(M, D, gridDim.x, blockIdx.x);
        pg8::EpiAdapt<EpiRes> E{EpiRes{P.H1, P.mod + 5 * D, P.out}};
        pg8::gemm_phase<pg8::EpiAdapt<EpiRes>, pg8::StaticOrder, true, true>(ldsl, g, So, E, tid);
    } SEAM(8);
    if (IN(9)) { const Ptrs P = mk_ptrs(a); const int lane = lane_id_asm(), tid = wave * 64 + lane; p8_ln_final(P, lane, wave); }
#undef IN
#undef SEAM
}

#ifndef MK_N_LAUNCHES
#define MK_N_LAUNCHES 1
#endif
extern "C" void kernel_launch(void* const* d_in, const int* in_sizes, int n_in, void* d_out, int out_size, void* d_ws, size_t ws_size, hipStream_t stream) {
    static int grid = 0;
    if (grid == 0) {
        if (n_in != 21 || in_sizes[0] != M * D || out_size != M * D || ws_size < WS_NEED) { fprintf(stderr, "kernel_launch: unexpected shapes (n_in %d, in0 %d, out %d, ws %zu)\n", n_in, n_in > 0 ? in_sizes[0] : -1, out_size, ws_size); grid = -1; return; }
        int dev = 0, cus = 0, per_cu = 0;
        if (hipGetDevice(&dev) != hipSuccess || hipDeviceGetAttribute(&cus, hipDeviceAttributeMultiprocessorCount, dev) != hipSuccess) { fprintf(stderr, "kernel_launch: device query failed\n"); grid = -1; return; }
        if (hipFuncSetAttribute((const void*)fwd_kernel, hipFuncAttributeMaxDynamicSharedMemorySize, LDS_BYTES) != hipSuccess) { fprintf(stderr, "kernel_launch: hipFuncSetAttribute failed\n"); grid = -1; return; }
        if (hipOccupancyMaxActiveBlocksPerMultiprocessor(&per_cu, (const void*)fwd_kernel, NTHREADS, LDS_BYTES) != hipSuccess || per_cu < 1) { fprintf(stderr, "kernel_launch: occupancy query says %d blocks per CU\n", per_cu); (void)hipGetLastError(); per_cu = 1; }
        grid = cus * (per_cu < 1 ? 1 : 1);
    }
    if (grid < 0) return;
    Args a{};
    for (int i = 0; i < 21; ++i) a.in[i] = d_in[i];
    a.out = (float*)d_out; a.ws = (unsigned char*)d_ws;
#if MK_N_LAUNCHES == 1
    a.ph_lo = 0; a.ph_hi = NPHASE;
    void* args[] = {&a};
    hipError_t e = hipLaunchCooperativeKernel((const void*)fwd_kernel, dim3(grid), dim3(NTHREADS), args, LDS_BYTES, stream);
    if (e != hipSuccess) fprintf(stderr, "kernel_launch: cooperative launch failed: %s (grid %d)\n", hipGetErrorString(e), grid);
#else
    for (int p = 0; p < NPHASE; ++p) { a.ph_lo = p; a.ph_hi = p + 1; hipLaunchKernelGGL(fwd_kernel, dim3(grid), dim3(NTHREADS), LDS_BYTES, stream, a); }
#endif
}
```

```cpp
#include <hip/hip_runtime.h>
#include <hip/hip_cooperative_groups.h>
#include <hip/hip_bf16.h>
#include <stdint.h>
#include <cstdio>
namespace cg = cooperative_groups;
namespace pg8 {
#define PG8_LAS __attribute__((address_space(3)))
typedef unsigned short bf16_t;
typedef short bf16x8 __attribute__((ext_vector_type(8)));
typedef float f32x4 __attribute__((ext_vector_type(4)));
typedef unsigned u32x4 __attribute__((ext_vector_type(4)));
constexpr int BM = 256, BK = 64, HALF = 128, HTB = HALF * BK * 2  , STAGE_BYTES = 8 * HTB, NXCD = 8, WGM = 8;

__host__ __device__ __forceinline__ int lds_byte(int r, int c) { const int st = (r >> 4) * 2 + (c >> 5), rr = r & 15, cc = c & 31, ob = rr * 64 + cc * 2; return st * 1024 + (ob ^ (((ob >> 9) & 1) << 5)); }
__host__ __device__ __forceinline__ void stage_rc(int b, int& R, int& C) { const int st = b / 1024, sb = b % 1024, swz = sb ^ (((sb >> 9) & 1) << 5); R = (st >> 1) * 16 + swz / 64; C = (st & 1) * 32 + (swz % 64) / 2; }
__host__ __device__ __forceinline__ int perm32(int rho) { const int n = rho >> 4, i = rho & 15; return 8 * (i >> 2) + 4 * n + (i & 3); }

struct Unit { int pm, pn; };
struct Gemm { const bf16_t* A; const bf16_t* Bt; int M, N, K; };

struct StaticOrder {
    int nM, nN, nwg, G, c;
    __host__ __device__ void init(int M, int N, int G_, int c_) { nM = M / BM; nN = N / BM; nwg = nM * nN; G = G_; c = c_; }
    __host__ __device__ bool next(int i, Unit& u) const {
        const long L = (long)i * G + c; if (L >= nwg) return false;
        int wgid = (int)L; { const int q = nwg / NXCD, r = nwg % NXCD, xcd = wgid % NXCD, off = wgid / NXCD; wgid = (xcd < r ? xcd * (q + 1) : r * (q + 1) + (xcd - r) * q) + off; }
        const int nig = WGM * nN, gid = wgid / nig, fm = gid * WGM, gsz = (nM - fm) < WGM ? (nM - fm) : WGM;
        u.pm = fm + ((wgid % nig) % gsz); u.pn = (wgid % nig) / gsz; return true;
    }
    __device__ __forceinline__ void a_ready(const Unit&) const {}
    __device__ __forceinline__ void done(const Unit&) const {}
};
template <class Epi, class Sched, bool ALIGN_EPI = false, bool SP2 = false>
__device__ __forceinline__ void gemm_phase(PG8_LAS unsigned char* lds, const Gemm g, const Sched& S, const Epi& E, const int tid_in) {
    const int tid = tid_in, wid = __builtin_amdgcn_readfirstlane(tid >> 6), lane = tid & 63, wr = wid >> 2, wc = wid & 3, fr = lane & 15, fq = lane >> 4;
    const int K = g.K, nt = K / BK;
    unsigned voffA[2], voffB[2];
#pragma unroll
    for (int i = 0; i < 2; ++i) { int R, C; stage_rc(tid * 16 + i * 8192, R, C); const int Rb = Epi::PERM ? ((R & ~31) + perm32(R & 31)) : R;
        voffA[i] = (unsigned)(R * K + C) * 2u; voffB[i] = (unsigned)(Rb * K + C) * 2u; }
    const size_t kstep = (size_t)(BK * 2);
    const size_t hstep = (size_t)HALF * K * 2;
    const size_t tstep = 2 * hstep;
    const unsigned ldsw = (unsigned)wid * 1024u;
    const int aoff = lds_byte(wr * 64 + fr, fq * 8), boff = lds_byte(wc * 32 + fr, fq * 8);
#define PG8_SA(b, h) (((b) * 2 + (h)) * HTB)
#define PG8_SB(b, h) ((4 + (b) * 2 + (h)) * HTB)
#define PG8_STAGE(bufoff, gbase, voff) do { _Pragma("unroll") for (int _i = 0; _i < 2; ++_i) \
        __builtin_amdgcn_global_load_lds((const unsigned*)((const char*)(gbase) + (voff)[_i]), (PG8_LAS unsigned*)(lds + (bufoff) + ldsw + _i * 8192), 16, 0, 0); } while (0)
#define PG8_LDA(dst, b, h) do { _Pragma("unroll") for (int m = 0; m < 4; ++m) _Pragma("unroll") for (int k = 0; k < 2; ++k) dst[m][k] = *(const PG8_LAS bf16x8*)(lds + PG8_SA(b, h) + aoff + m * 2048 + k * 1024); } while (0)
#define PG8_LDB(dst, b, h) do { _Pragma("unroll") for (int n = 0; n < 2; ++n) _Pragma("unroll") for (int k = 0; k < 2; ++k) dst[n][k] = *(const PG8_LAS bf16x8*)(lds + PG8_SB(b, h) + boff + n * 2048 + k * 1024); } while (0)
#define PG8_MMA(ai, bj, At, Bt) do { __builtin_amdgcn_s_setprio(1); _Pragma("unroll") for (int m = 0; m < 4; ++m) _Pragma("unroll") for (int n = 0; n < 2; ++n) _Pragma("unroll") for (int k = 0; k < 2; ++k) \
        acc[ai][bj][m][n] = __builtin_amdgcn_mfma_f32_16x16x32_bf16(Bt[n][k], At[m][k], acc[ai][bj][m][n], 0, 0, 0); __builtin_amdgcn_s_setprio(0); } while (0)
#define PG8_WAIT_V(n) asm volatile("s_waitcnt vmcnt(" #n ")" ::: "memory")
#define PG8_WAIT_L(n) asm volatile("s_waitcnt lgkmcnt(" #n ")" ::: "memory")
#define PG8_BAR __builtin_amdgcn_s_barrier()
#define PG8_SCHED __builtin_amdgcn_sched_barrier(0)
    Unit cur, nxt; int ui = 0;
    if (!S.next(0, cur)) return;
    f32x4 acc[2][2][4][2];
#pragma unroll
    for (int a = 0; a < 2; ++a)
#pragma unroll
        for (int b = 0; b < 2; ++b)
#pragma unroll
            for (int m = 0; m < 4; ++m)
#pragma unroll
                for (int n = 0; n < 2; ++n) acc[a][b][m][n] = (f32x4){0.f, 0.f, 0.f, 0.f};
    bf16x8 At[4][2], B0[2][2], B1[2][2];
    const char* cA = (const char*)g.A + (size_t)cur.pm * tstep; const char* cB = (const char*)g.Bt + (size_t)cur.pn * tstep;
    S.a_ready(cur);
    if constexpr (SP2) {
        PG8_STAGE(PG8_SB(0, 0), cB, voffB); PG8_STAGE(PG8_SB(0, 1), cB + hstep, voffB); PG8_STAGE(PG8_SA(0, 0), cA, voffA); PG8_STAGE(PG8_SA(0, 1), cA + hstep, voffA);
        if (wr == 1) PG8_BAR;
        PG8_WAIT_V(2); PG8_BAR;
        PG8_STAGE(PG8_SB(1, 0), cB + kstep, voffB); PG8_STAGE(PG8_SA(1, 0), cA + kstep, voffA); PG8_STAGE(PG8_SB(1, 1), cB + hstep + kstep, voffB);
        PG8_WAIT_V(6); PG8_BAR;
    } else {
        PG8_STAGE(PG8_SB(0, 0), cB, voffB); PG8_STAGE(PG8_SA(0, 0), cA, voffA); PG8_STAGE(PG8_SB(0, 1), cB + hstep, voffB); PG8_STAGE(PG8_SA(0, 1), cA + hstep, voffA);
        if (wr == 1) PG8_BAR;
        PG8_WAIT_V(4); PG8_BAR;
        PG8_STAGE(PG8_SB(1, 0), cB + kstep, voffB); PG8_STAGE(PG8_SA(1, 0), cA + kstep, voffA); PG8_STAGE(PG8_SB(1, 1), cB + hstep + kstep, voffB);
        PG8_WAIT_V(6); PG8_BAR;
    }
    for (;;) {
        const bool has_next = S.next(ui + 1, nxt);
        const char* nA = has_next ? (const char*)g.A + (size_t)nxt.pm * tstep : cA; const char* nB = has_next ? (const char*)g.Bt + (size_t)nxt.pn * tstep : cB;
        for (int t = 0; t < nt; t += 2) {
            const bool last = (t == nt - 2);
            const char* a1 = cA + (size_t)(t + 1) * kstep;
            const char* a2 = last ? nA : cA + (size_t)(t + 2) * kstep; const char* b2 = last ? nB : cB + (size_t)(t + 2) * kstep;
            const char* a3 = a2 + kstep; const char* b3 = b2 + kstep;
            if (last && has_next) S.a_ready(nxt);
            if constexpr (SP2) {
            PG8_LDB(B0, 0, 0); PG8_LDB(B1, 0, 1); PG8_SCHED; PG8_LDA(At, 0, 0); PG8_STAGE(PG8_SA(1, 1), a1 + hstep, voffA);
            PG8_WAIT_V(8); PG8_WAIT_L(0); PG8_BAR; PG8_MMA(0, 0, At, B0); PG8_MMA(0, 1, At, B1); PG8_BAR; PG8_SCHED;
            PG8_LDA(At, 0, 1); PG8_STAGE(PG8_SB(0, 0), b2, voffB); PG8_STAGE(PG8_SB(0, 1), b2 + hstep, voffB); PG8_STAGE(PG8_SA(0, 0), a2, voffA);
            PG8_WAIT_V(8); PG8_WAIT_L(0); PG8_BAR; PG8_MMA(1, 0, At, B0); PG8_MMA(1, 1, At, B1); PG8_BAR; PG8_SCHED;
            PG8_LDB(B0, 1, 0); PG8_LDB(B1, 1, 1); PG8_SCHED; PG8_LDA(At, 1, 0); PG8_STAGE(PG8_SA(0, 1), a2 + hstep, voffA);
            PG8_WAIT_V(8); PG8_WAIT_L(0); PG8_BAR; PG8_MMA(0, 0, At, B0); PG8_MMA(0, 1, At, B1); PG8_BAR; PG8_SCHED;
            PG8_LDA(At, 1, 1); PG8_STAGE(PG8_SB(1, 0), b3, voffB); PG8_STAGE(PG8_SB(1, 1), b3 + hstep, voffB); PG8_STAGE(PG8_SA(1, 0), a3, voffA);
            PG8_WAIT_V(8); PG8_WAIT_L(0); PG8_BAR; PG8_MMA(1, 0, At, B0); PG8_MMA(1, 1, At, B1); PG8_BAR; PG8_SCHED;
            } else {
            PG8_LDB(B0, 0, 0); PG8_SCHED; PG8_LDA(At, 0, 0); PG8_STAGE(PG8_SA(1, 1), a1 + hstep, voffA);
            PG8_WAIT_L(8); PG8_BAR; PG8_WAIT_L(0); PG8_MMA(0, 0, At, B0); PG8_BAR; PG8_SCHED;
            PG8_LDB(B1, 0, 1); PG8_STAGE(PG8_SB(0, 0), b2, voffB);
            PG8_BAR; PG8_WAIT_L(0); PG8_MMA(0, 1, At, B1); PG8_BAR;
            PG8_LDA(At, 0, 1); PG8_STAGE(PG8_SA(0, 0), a2, voffA);
            PG8_BAR; PG8_WAIT_L(0); PG8_MMA(1, 0, At, B0); PG8_BAR; PG8_SCHED;
            PG8_STAGE(PG8_SB(0, 1), b2 + hstep, voffB);
            PG8_WAIT_V(6); PG8_BAR; PG8_MMA(1, 1, At, B1); PG8_BAR;
            PG8_LDB(B0, 1, 0); PG8_SCHED; PG8_LDA(At, 1, 0); PG8_STAGE(PG8_SA(0, 1), a2 + hstep, voffA);
            PG8_WAIT_L(8); PG8_BAR; PG8_WAIT_L(0); PG8_MMA(0, 0, At, B0); PG8_BAR; PG8_SCHED;
            PG8_LDB(B1, 1, 1); PG8_STAGE(PG8_SB(1, 0), b3, voffB);
            PG8_BAR; PG8_WAIT_L(0); PG8_MMA(0, 1, At, B1); PG8_BAR;
            PG8_LDA(At, 1, 1); PG8_STAGE(PG8_SA(1, 0), a3, voffA);
            PG8_BAR; PG8_WAIT_L(0); PG8_MMA(1, 0, At, B0); PG8_BAR; PG8_SCHED;
            PG8_STAGE(PG8_SB(1, 1), b3 + hstep, voffB);
            PG8_WAIT_V(6); PG8_BAR; PG8_MMA(1, 1, At, B1); PG8_BAR;
            }
        }
        if constexpr (ALIGN_EPI) { if (wr == 0) PG8_BAR; }
        if constexpr (!Epi::AFTER_DRAIN) { E(acc, cur, wr, wc, fr, fq); S.done(cur); }
        if (!has_next) break;
#pragma unroll
        for (int a = 0; a < 2; ++a)
#pragma unroll
            for (int b = 0; b < 2; ++b)
#pragma unroll
                for (int m = 0; m < 4; ++m)
#pragma unroll
                    for (int n = 0; n < 2; ++n) acc[a][b][m][n] = (f32x4){0.f, 0.f, 0.f, 0.f};
        cur = nxt; cA = nA; cB = nB; ++ui;
        if constexpr (ALIGN_EPI) { if (wr == 1) PG8_BAR; }
    }
    PG8_WAIT_V(0);
    if constexpr (!ALIGN_EPI) { if (wr == 0) PG8_BAR; }
    PG8_BAR;
    if constexpr (Epi::AFTER_DRAIN) { E.fused(acc, cur, wr, wc, fr, fq, lds, wid, lane); S.done(cur); }
#undef PG8_SA
#undef PG8_SB
#undef PG8_STAGE
#undef PG8_LDA
#undef PG8_LDB
#undef PG8_MMA
#undef PG8_WAIT_V
#undef PG8_WAIT_L
#undef PG8_BAR
#undef PG8_SCHED
}
}
namespace attn {
constexpr int D = 128, LDR = 1024;
constexpr float SCALE = 0.6931471805599453f;
constexpr float THR = 8.f;
constexpr bool WSKIP = false;
constexpr int NW = 8, QBLK = 32, KVBLK = 64, QB = NW * QBLK;
constexpr int SHM_V = KVBLK * D * 2, SHM_K = KVBLK * D * 2;
constexpr int LDS_BYTES = 2 * SHM_V + 2 * SHM_K + NW * 64 * 4;
using bf16 = __hip_bfloat16;
typedef short bf16x8 __attribute__((ext_vector_type(8)));
typedef short s16x4 __attribute__((ext_vector_type(4)));
typedef float f32x16 __attribute__((ext_vector_type(16)));
typedef float f32x4 __attribute__((ext_vector_type(4)));
typedef unsigned u32x4 __attribute__((ext_vector_type(4)));
template <class A, class Bt> struct same_t { static constexpr bool v = false; };
template <class A> struct same_t<A, A> { static constexpr bool v = true; };

#define KSWZ(row, colB) ((row) * 256 + ((colB) ^ (((row) & 7) << 4)))
#define SBAR() __builtin_amdgcn_sched_barrier(0)
__device__ __forceinline__ int v_st(int k, int c) { const int kk = (k & ~0xC) | ((k & 4) << 1) | ((k & 8) >> 1); return ((kk >> 3) * 4 + (c >> 5)) * 512 + ((kk & 7) * 32 + (c & 31)) * 2; }
__device__ __forceinline__ int v_rd_base(int lane) { return ((lane & 3) << 3) | (((lane >> 2) & 3) << 6) | (((lane >> 4) & 1) << 5) | (((lane >> 5) & 1) << 8); }
constexpr int v_rd_off(int d0, int ks, int half) { return d0 * 512 + ks * 4096 + half * 2048; }
__device__ __forceinline__ int crow(int r, int hi) { return (r & 3) + 8 * (r >> 2) + 4 * hi; }
__device__ __forceinline__ unsigned cvtpk(float lo, float hi) {
    unsigned r; asm volatile("v_cvt_pk_bf16_f32 %0, %1, %2" : "=v"(r) : "v"(lo), "v"(hi)); return r;
}
__device__ __forceinline__ bf16x8 pack8(f32x4 a, f32x4 b) {
    u32x4 w = {cvtpk(a[0], a[1]), cvtpk(a[2], a[3]), cvtpk(b[0], b[1]), cvtpk(b[2], b[3])};
    return *reinterpret_cast<bf16x8*>(&w);
}
template <class T> __device__ __forceinline__ bf16x8 load8(const T* p) {
    if constexpr (same_t<T, float>::v) { return pack8(*(const f32x4*)p, *(const f32x4*)(p + 4)); }
    else { return *reinterpret_cast<const bf16x8*>(p); }
}
__device__ __forceinline__ void mask_tile(f32x16& p0, f32x16& p1, int dq, unsigned W) {
    const float NEG = -__builtin_inff();
#pragma unroll
    for (int r = 0; r < 16; ++r) {
        const int c = (r & 3) + 8 * (r >> 2);
        if ((unsigned)(dq - c) >= W) p0[r] = NEG;
        if ((unsigned)(dq - c - 32) >= W) p1[r] = NEG;
    }
}
__device__ __forceinline__ void partialSM(f32x16& p0, f32x16& p1, float& m_reg, float& mn, float& alpha) {
    float pmax = p0[0]; for (int r = 1; r < 16; ++r) pmax = fmaxf(pmax, p0[r]); for (int r = 0; r < 16; ++r) pmax = fmaxf(pmax, p1[r]);
    { auto rr = __builtin_amdgcn_permlane32_swap(__float_as_uint(pmax), __float_as_uint(pmax), false, false);
      pmax = fmaxf(__uint_as_float(rr[0]), __uint_as_float(rr[1])); }
    constexpr float C2 = 1.4426950408889634f * SCALE;
    if (__builtin_expect(__all((pmax - m_reg) * SCALE <= THR), 1)) { mn = m_reg; alpha = 1.f; }
    else { mn = fmaxf(m_reg, pmax); alpha = __builtin_amdgcn_exp2f((m_reg - mn) * C2); m_reg = mn; }
    const float mnL = -mn * C2;
    for (int r = 0; r < 16; ++r) p0[r] = fmaf(p0[r], C2, mnL); for (int r = 0; r < 16; ++r) p1[r] = fmaf(p1[r], C2, mnL);
    for (int r = 0; r < 16; ++r) p0[r] = __builtin_amdgcn_exp2f(p0[r]);
}
__device__ __forceinline__ void finishSM(f32x16& p0, f32x16& p1, float alpha, float& l_reg, bf16x8& pa0, bf16x8& pa1, bf16x8& pa2, bf16x8& pa3) {
    for (int r = 0; r < 16; ++r) p1[r] = __builtin_amdgcn_exp2f(p1[r]);
    float ps = 0; for (int r = 0; r < 16; ++r) ps += p0[r]; for (int r = 0; r < 16; ++r) ps += p1[r];
    { auto rr = __builtin_amdgcn_permlane32_swap(__float_as_uint(ps), __float_as_uint(ps), false, false);
      ps = __uint_as_float(rr[0]) + __uint_as_float(rr[1]); }
    l_reg = l_reg * alpha + ps;
#define PK4(P, B_, OUT) do { unsigned a0 = cvtpk(P[B_+0], P[B_+1]), a1 = cvtpk(P[B_+2], P[B_+3]);                          \
        unsigned b0 = cvtpk(P[B_+4], P[B_+5]), b1 = cvtpk(P[B_+6], P[B_+7]);                                             \
        auto r0 = __builtin_amdgcn_permlane32_swap(a0, b0, false, false); auto r1 = __builtin_amdgcn_permlane32_swap(a1, b1, false, false); \
        u32x4 w = {r0[0], r1[0], r0[1], r1[1]}; OUT = *reinterpret_cast<bf16x8*>(&w); } while (0)
    PK4(p0, 0, pa0); PK4(p0, 8, pa1); PK4(p1, 0, pa2); PK4(p1, 8, pa3);
#undef PK4
}
template <int KB, bool SK>
__device__ __forceinline__ void qkt(f32x16& p0, f32x16& p1, const char* K_lds, int r32, int hi, const bf16x8* qr, bool act) {
    if (SK && !act) { const float NEG = -__builtin_inff();
#pragma unroll
        for (int r = 0; r < 16; ++r) { p0[r] = NEG; p1[r] = NEG; } return; }
    p0 = f32x16{}; p1 = f32x16{};
    const char* kb[4];
#pragma unroll
    for (int dd = 0; dd < 4; ++dd) kb[dd] = K_lds + KB * SHM_K + KSWZ(r32, (dd * 16 + hi * 8) * 2);
#pragma unroll
    for (int d0 = 0; d0 < 8; ++d0) { const char* a = kb[d0 & 3] + (d0 >> 2) * 128;
        bf16x8 b0 = *reinterpret_cast<const bf16x8*>(a);
        bf16x8 b1 = *reinterpret_cast<const bf16x8*>(a + 32 * 256);
        p0 = __builtin_amdgcn_mfma_f32_32x32x16_bf16(b0, qr[d0], p0, 0, 0, 0);
        p1 = __builtin_amdgcn_mfma_f32_32x32x16_bf16(b1, qr[d0], p1, 0, 0, 0); }
}
template <int VB, bool SK>
__device__ __forceinline__ void pv_tile(f32x16* o, int vb0, bf16x8 pa0, bf16x8 pa1, bf16x8 pa2, bf16x8 pa3, bool act) {
    if (SK && !act) return;
#define TRRD(dst, off) asm volatile("ds_read_b64_tr_b16 %0, %1 offset:%2" : "=&v"(dst) : "v"(vb0), "i"(off) : "memory")
#define PV_D0(d0) do { s16x4 l0, l1, l2, l3, h0, h1, h2, h3; constexpr int b_ = VB * SHM_V + v_rd_off(d0, 0, 0);     \
        TRRD(l0, b_); TRRD(h0, b_ + 2048); TRRD(l1, b_ + 4096); TRRD(h1, b_ + 6144); TRRD(l2, b_ + 8192); TRRD(h2, b_ + 10240); TRRD(l3, b_ + 12288); TRRD(h3, b_ + 14336); \
        asm volatile("s_waitcnt lgkmcnt(0)" ::: "memory"); SBAR();                 \
        o[d0] = __builtin_amdgcn_mfma_f32_32x32x16_bf16(pa0, (bf16x8){l0[0], l0[1], l0[2], l0[3], h0[0], h0[1], h0[2], h0[3]}, o[d0], 0, 0, 0);   \
        o[d0] = __builtin_amdgcn_mfma_f32_32x32x16_bf16(pa1, (bf16x8){l1[0], l1[1], l1[2], l1[3], h1[0], h1[1], h1[2], h1[3]}, o[d0], 0, 0, 0);   \
        o[d0] = __builtin_amdgcn_mfma_f32_32x32x16_bf16(pa2, (bf16x8){l2[0], l2[1], l2[2], l2[3], h2[0], h2[1], h2[2], h2[3]}, o[d0], 0, 0, 0);   \
        o[d0] = __builtin_amdgcn_mfma_f32_32x32x16_bf16(pa3, (bf16x8){l3[0], l3[1], l3[2], l3[3], h3[0], h3[1], h3[2], h3[3]}, o[d0], 0, 0, 0); } while (0)
    PV_D0(0); PV_D0(1); PV_D0(2); PV_D0(3);
#undef PV_D0
#undef TRRD
}

template <class TIn, class TOut> struct BlockRef { const TIn* Q; const TIn* K; const TIn* V; TOut* O; int P0; };
template <class TIn> struct Seam {
    bf16x8 qr[8];
    bf16x8 st_v0, st_v1, st_k0, st_k1; f32x4 sf0, sf1, sf2, sf3;
    f32x4 tq[16];
};
__device__ __forceinline__ int swa_jlo(int P0, int W) { const int lowk = P0 - W + 1; return lowk > 0 ? lowk / KVBLK : 0; }
#define ROW(p, k0, rr) ((p) + (size_t)((k0) + (rr)) * LDR + sc)
#define VMW() asm volatile("s_waitcnt vmcnt(0)" ::: "memory")
#define VMWN(n) asm volatile("s_waitcnt vmcnt(%0)" :: "i"(n) : "memory")
#define SLOAD_H(Kp, Vp, k0) do { S.st_v0 = load8<TIn>(ROW(Vp, k0, sr)); S.st_v1 = load8<TIn>(ROW(Vp, k0, 32 + sr));              \
                         S.st_k0 = load8<TIn>(ROW(Kp, k0, sr)); S.st_k1 = load8<TIn>(ROW(Kp, k0, 32 + sr)); } while (0)
#define SWRITE_HK(bf) do { *(bf16x8*)(K_lds + (bf) * SHM_K + kws) = S.st_k0; *(bf16x8*)(K_lds + (bf) * SHM_K + kws + 32 * 256) = S.st_k1; } while (0)
#define SWRITE_HV(bf) do { *(bf16x8*)(V_lds + (bf) * SHM_V + vst0) = S.st_v0; *(bf16x8*)(V_lds + (bf) * SHM_V + vst1) = S.st_v1; } while (0)
#define SWRITE_H(bf) do { SWRITE_HV(bf); SWRITE_HK(bf); } while (0)
#define SLOAD_F(p, k0) do { S.sf0 = *(const f32x4*)ROW(p, k0, sr); S.sf1 = *(const f32x4*)(ROW(p, k0, sr) + 4);                \
                            S.sf2 = *(const f32x4*)ROW(p, k0, 32 + sr); S.sf3 = *(const f32x4*)(ROW(p, k0, 32 + sr) + 4); } while (0)
#define SWRITE_KF(bf) do { *(bf16x8*)(K_lds + (bf) * SHM_K + kws) = pack8(S.sf0, S.sf1); *(bf16x8*)(K_lds + (bf) * SHM_K + kws + 32 * 256) = pack8(S.sf2, S.sf3); } while (0)
#define SWRITE_VF(bf) do { *(bf16x8*)(V_lds + (bf) * SHM_V + vst0) = pack8(S.sf0, S.sf1); *(bf16x8*)(V_lds + (bf) * SHM_V + vst1) = pack8(S.sf2, S.sf3); } while (0)
template <class TIn, class TOut>
__device__ __forceinline__ void causal_swa_prime(const BlockRef<TIn, TOut>& cur, int W, char* lds, Seam<TIn>& S, const int tid_in) {
    constexpr bool F32 = same_t<TIn, float>::v;
    const int tid = tid_in, wid = __builtin_amdgcn_readfirstlane(tid >> 6), lane = tid & 63, r32 = lane & 31, hi = lane >> 5;
    const int sr = tid >> 4, sc = (tid & 15) * 8, kws = KSWZ(sr, sc * 2); char* K_lds = lds + 2 * SHM_V;
    const int kb0 = swa_jlo(cur.P0, W) * KVBLK;
    for (int d0 = 0; d0 < 8; ++d0) S.qr[d0] = load8<TIn>(cur.Q + (size_t)(wid * QBLK + r32) * LDR + d0 * 16 + hi * 8);
    if constexpr (F32) { SLOAD_F((const float*)cur.K, kb0); VMW(); SWRITE_KF(0); SBAR(); SLOAD_F((const float*)cur.V, kb0); }
    else { SLOAD_H(cur.K, cur.V, kb0); VMW(); SWRITE_HK(0); }
    __syncthreads();
}
template <class TIn, class TOut>
__device__ __forceinline__ void causal_swa_block(const BlockRef<TIn, TOut>& cur, const BlockRef<TIn, TOut>& nxt, int skv, int W, char* lds, Seam<TIn>& S, const int tid_in) {
    constexpr bool F32 = same_t<TIn, float>::v;
    const int tid = tid_in, wid = __builtin_amdgcn_readfirstlane(tid >> 6), lane = tid & 63, r32 = lane & 31, hi = lane >> 5;
    const int j_lo = swa_jlo(cur.P0, W);
    int j_hi = (cur.P0 + QB - 1) / KVBLK + 1; if (j_hi > skv / KVBLK) j_hi = skv / KVBLK;
    const int NT = j_hi - j_lo;
    const int kbn = swa_jlo(nxt.P0, W) * KVBLK;
    const int qlo = cur.P0 + wid * QBLK, qm = qlo + r32 - 4 * hi;
    char* V_lds = lds; char* K_lds = lds + 2 * SHM_V;
    float* ws = (float*)(lds + 2 * SHM_V + 2 * SHM_K) + wid * 64; float* li_l = ws, * al_l = ws + 32;
    float m_reg = -1e30f, l_reg = 0; f32x16 o[4] = {};
    const int sr = tid >> 4, sc = (tid & 15) * 8, vst0 = v_st(sr, sc), vst1 = v_st(32 + sr, sc), kws = KSWZ(sr, sc * 2);
    const int vb0 = (int)(uintptr_t)V_lds + v_rd_base(lane);
    const TIn* Kh = cur.K; const TIn* Vh = cur.V;
#define RESC(a) do { if (__any((a) < 1.f)) { if (hi == 0) al_l[r32] = (a); asm volatile("s_waitcnt lgkmcnt(0)" ::: "memory");              \
                     for (int d_ = 0; d_ < 4; ++d_) for (int r = 0; r < 16; ++r) o[d_][r] *= al_l[crow(r, hi)]; } } while (0)
#define KBASE(t) ((j_lo + (t)) * KVBLK)
#define ACT(t) (KBASE(t) <= qlo + QBLK - 1 && KBASE(t) + KVBLK - 1 >= qlo - W + 1)
#define MASKT(P0_, P1_, t) do { const int kb_ = KBASE(t); if ((!SK || ACT(t)) && (kb_ + KVBLK - 1 > qlo || kb_ <= qlo + QBLK - 1 - W)) mask_tile(P0_, P1_, qm - kb_, (unsigned)W); } while (0)
    constexpr int NQL = F32 ? 16 : 8;
    constexpr bool SK = WSKIP && !F32;
#define SEAM_K0() do { VMWN(NQL); if constexpr (F32) { SWRITE_KF(0); SBAR(); SLOAD_F((const float*)nxt.V, kbn); } else { SWRITE_HK(0); } SBAR(); } while (0)
    f32x16 pA0, pA1, pB0, pB1; float mnA, mnB, alA, alB; bf16x8 pa0, pa1, pa2, pa3;
    if constexpr (F32) { VMW(); SWRITE_VF(0); SBAR(); } else { SWRITE_HV(0); SBAR(); }
    if (NT > 1) { if constexpr (F32) SLOAD_F((const float*)Kh, KBASE(1)); else SLOAD_H(Kh, Vh, KBASE(1)); }
    SBAR(); qkt<0, SK>(pA0, pA1, K_lds, r32, hi, S.qr, ACT(0));
    if constexpr (F32) { if (NT > 1) { VMW(); SWRITE_KF(1); SBAR(); SLOAD_F((const float*)Vh, KBASE(1)); } }
    MASKT(pA0, pA1, 0); partialSM(pA0, pA1, m_reg, mnA, alA);
    if (NT > 1) { VMW(); if constexpr (F32) { SWRITE_VF(1); SBAR(); if (NT > 2) SLOAD_F((const float*)Kh, KBASE(2)); } else SWRITE_H(1); }
    __syncthreads();
#define HALF_STEP(PX0, PX1, mnX, alX, PY0, PY1, alY, t, KB, VB, SB) do {                                                      \
        SBAR(); qkt<KB, SK>(PX0, PX1, K_lds, r32, hi, S.qr, ACT(t));                                             \
        finishSM(PY0, PY1, alY, l_reg, pa0, pa1, pa2, pa3); SBAR();                                                           \
        if ((t) + 1 < NT) { if constexpr (F32) { VMW(); SWRITE_KF(SB); SBAR(); SLOAD_F((const float*)Vh, KBASE((t) + 1)); }  \
                            else { SLOAD_H(Kh, Vh, KBASE((t) + 1)); } SBAR(); }                                               \
        pv_tile<VB, SK>(o, vb0, pa0, pa1, pa2, pa3, ACT((t) - 1)); MASKT(PX0, PX1, (t)); partialSM(PX0, PX1, m_reg, mnX, alX);                                        \
        __syncthreads();                                                                                                      \
        if ((t) + 1 < NT) { VMW(); if constexpr (F32) { SWRITE_VF(SB); SBAR(); if ((t) + 2 < NT) SLOAD_F((const float*)Kh, KBASE((t) + 2)); } \
                            else { SWRITE_H(SB); } }                                                                          \
        RESC(alX); __syncthreads(); } while (0)
    for (int t = 1; t + 1 < NT; t += 2) {
        HALF_STEP(pB0, pB1, mnB, alB, pA0, pA1, alA, t, 1, 0, 0);
        HALF_STEP(pA0, pA1, mnA, alA, pB0, pB1, alB, t + 1, 0, 1, 1);
    }
    const bool even = (NT & 1) == 0;
    if (even) { SBAR(); qkt<1, SK>(pB0, pB1, K_lds, r32, hi, S.qr, ACT(NT - 1)); SBAR(); }
#define QROW(e) (nxt.Q + (size_t)(wid * QBLK + r32) * LDR + ((e) >> 1) * 16 + hi * 8 + ((e) & 1) * 4)
    if constexpr (F32) { SLOAD_F((const float*)nxt.K, kbn); SBAR();
#pragma unroll
        for (int e = 0; e < 8; ++e) S.tq[e] = *(const f32x4*)QROW(e); }
    else { SLOAD_H(nxt.K, nxt.V, kbn); SBAR();
#pragma unroll
        for (int d0 = 0; d0 < 8; ++d0) S.qr[d0] = load8<TIn>(nxt.Q + (size_t)(wid * QBLK + r32) * LDR + d0 * 16 + hi * 8); }
    SBAR();
    finishSM(pA0, pA1, alA, l_reg, pa0, pa1, pa2, pa3); SBAR();
    if constexpr (F32) {
#pragma unroll
        for (int e = 8; e < 16; ++e) S.tq[e] = *(const f32x4*)QROW(e); SBAR(); }
#undef QROW
    pv_tile<0, SK>(o, vb0, pa0, pa1, pa2, pa3, ACT(even ? NT - 2 : NT - 1));
    if (even) { MASKT(pB0, pB1, NT - 1); partialSM(pB0, pB1, m_reg, mnB, alB); __syncthreads(); RESC(alB);
        finishSM(pB0, pB1, alB, l_reg, pa0, pa1, pa2, pa3); SBAR(); pv_tile<1, SK>(o, vb0, pa0, pa1, pa2, pa3, ACT(NT - 1)); }
    SBAR(); SEAM_K0();
    if (hi == 0) li_l[r32] = l_reg; asm volatile("s_waitcnt lgkmcnt(0)" ::: "memory");
    float rli[16];
#pragma unroll
    for (int r = 0; r < 16; ++r) rli[r] = __builtin_amdgcn_rcpf(li_l[crow(r, hi)]);
    TOut* Ow = cur.O + (size_t)(wid * QBLK) * LDR;
    if constexpr (same_t<TOut, float>::v) {
#pragma unroll
        for (int r = 0; r < 16; ++r) { const int orow = crow(r, hi);
#pragma unroll
            for (int d0 = 0; d0 < 4; ++d0) Ow[(size_t)orow * LDR + d0 * 32 + r32] = o[d0][r] * rli[r]; }
    } else {
        unsigned short* stg = (unsigned short*)(lds + LDS_BYTES) + wid * 4096;
        int hi_e = hi, r32_e = r32, lane_e = lane; asm volatile("" : "+v"(hi_e), "+v"(r32_e), "+v"(lane_e));
#pragma unroll
        for (int r = 0; r < 16; ++r) { const int orow = crow(r, hi_e);
#pragma unroll
            for (int d0 = 0; d0 < 4; ++d0) stg[orow * 128 + d0 * 32 + r32_e] = (unsigned short)cvtpk(o[d0][r] * rli[r], 0.f); }
        asm volatile("s_waitcnt lgkmcnt(0)" ::: "memory");
#pragma unroll
        for (int i = 0; i < 8; ++i) { const int row = i * 4 + (lane_e >> 4), ch = lane_e & 15; const u32x4 v = *(const u32x4*)(stg + row * 128 + ch * 8); *(u32x4*)(Ow + (unsigned)(row * LDR + ch * 8)) = v; }
    }
    if constexpr (F32) {
#pragma unroll
        for (int d0 = 0; d0 < 8; ++d0) S.qr[d0] = pack8(S.tq[2 * d0], S.tq[2 * d0 + 1]); }
    __syncthreads();
#undef RESC
#undef KBASE
#undef ACT
#undef MASKT
#undef SEAM_K0
#undef HALF_STEP
}
#undef ROW
#undef VMW
#undef VMWN
#undef SLOAD_H
#undef SWRITE_HK
#undef SWRITE_HV
#undef SWRITE_H
#undef SLOAD_F
#undef SWRITE_KF
#undef SWRITE_VF

}
namespace pg8 {
template <class F> struct EpiAdapt {
    static constexpr bool PERM = true, AFTER_DRAIN = false; F f;
    __device__ __forceinline__ void operator()(const f32x4 (&acc)[2][2][4][2], const Unit& u, int wr, int wc, int fr, int fq) const {
        const int c = wc * 32 + fq * 8;
#pragma unroll
        for (int ai = 0; ai < 2; ++ai)
#pragma unroll
            for (int m = 0; m < 4; ++m) {
                const int row = u.pm * BM + ai * HALF + wr * 64 + m * 16 + fr;
                float lo[8], hi[8];
#pragma unroll
                for (int j = 0; j < 4; ++j) { lo[j] = acc[ai][0][m][0][j]; lo[4 + j] = acc[ai][0][m][1][j]; hi[j] = acc[ai][1][m][0][j]; hi[4 + j] = acc[ai][1][m][1][j]; }
                f(row, u.pn, c, lo, hi);
            }
    }
};
}

typedef unsigned short bf16_t;
typedef short bf16x8 __attribute__((ext_vector_type(8)));
typedef float f32x4 __attribute__((ext_vector_type(4)));
typedef unsigned u32x4 __attribute__((ext_vector_type(4)));
#define LAS __attribute__((address_space(3)))

constexpr int D = 2048, NB = 4, S = 4096, M = NB * S, NIN = 7168, DFF = 5632, NGU = 2 * DFF;
constexpr float LN_EPS = 1e-5f, RMS_EPS = 1e-6f;
constexpr float ALPHA = 1.189207115002721f;
constexpr float LAMBDA_INIT = 0.2f;
constexpr float LOG2E = 1.4426950408889634f;
constexpr float QSCALE = 0.08838834764831845f;
constexpr int NWAVES = 8, NTHREADS = 512;
constexpr int LDS_BYTES = 147456;

constexpr size_t MiB = 1u << 20;
constexpr size_t OFF_BAR = 0;
constexpr size_t OFF_MOD = 64 * 1024, OFF_LB = 320 * 1024, OFF_LAM = 328 * 1024;
constexpr size_t OFF_COS = 1 * MiB, OFF_SIN = 5 * MiB;
constexpr size_t OFF_WIN = 16 * MiB, OFF_WO = 44 * MiB, OFF_WGU = 52 * MiB, OFF_WD = 96 * MiB;
constexpr size_t OFF_U = 120 * MiB, OFF_MIX = 184 * MiB;
constexpr size_t OFF_QH = 248 * MiB, OFF_VH = 280 * MiB, OFF_GH = 312 * MiB, OFF_LOGF = 344 * MiB, OFF_QA = 408 * MiB, OFF_KA = 440 * MiB, OFF_VA = 472 * MiB;
constexpr size_t OFF_T1 = 248 * MiB, OFF_H1 = 376 * MiB, OFF_HFF = 184 * MiB;
constexpr size_t OFF_O1 = 120 * MiB, OFF_O2 = 152 * MiB;
constexpr size_t WS_NEED = 504 * MiB;

__device__ __forceinline__ float bf2f(bf16_t v) { return __uint_as_float((unsigned)v << 16); }
__device__ __forceinline__ bf16_t f2bf(float f) { unsigned u = __float_as_uint(f); return (bf16_t)((u + 0x7fffu + ((u >> 16) & 1u)) >> 16); }
__device__ __forceinline__ unsigned pk2(float lo, float hi) { return (unsigned)f2bf(lo) | ((unsigned)f2bf(hi) << 16); }
__device__ __forceinline__ float sigmoidf_(float x) { return 1.f / (1.f + __expf(-x)); }
__device__ __forceinline__ float wave_sum(float v) {
#pragma unroll
    for (int o = 1; o < 64; o <<= 1) v += __shfl_xor(v, o);
    return v;
}

struct Ptrs {
    const float *x, *c; const int* positions; const float *w_ada, *b_ada, *w_in, *lb_logits, *hg_norm_w, *lq1, *lk1, *lq2, *lk2, *subln_w, *w_out, *ln1_g, *ln1_b, *w_gate, *w_up, *w_down, *ln2_g, *ln2_b;
    float* out; float *mod, *lbv, *lam, *cosT, *sinT; bf16_t *WinT, *WoT, *WguT, *WdT, *U, *MIX, *Qh, *Vh, *Gh, *Qa, *Ka, *Va, *Hff, *O1, *O2; float *Logf, *T1, *H1;
};

struct Epi1 {
    bf16_t *Qh, *Vh, *Gh, *Qa, *Ka, *Va; float* Logf; const float *lbv, *cosT, *sinT;
    __device__ __forceinline__ void operator()(int row, int pn, int c, const float (&lo)[8], const float (&hi)[8]) const {
        const int seg = pn >> 2, pt = pn & 3;
        if (seg == 4 || seg == 5) {
            const int head = 2 * pt + (c >> 6), d0 = c & 63; const float sc = (seg == 4) ? QSCALE * LOG2E : 1.f;
            const f32x4 c0 = *(const f32x4*)(cosT + (size_t)row * 64 + d0), c1 = *(const f32x4*)(cosT + (size_t)row * 64 + d0 + 4);
            const f32x4 s0 = *(const f32x4*)(sinT + (size_t)row * 64 + d0), s1 = *(const f32x4*)(sinT + (size_t)row * 64 + d0 + 4);
            float o1[8], o2[8];
#pragma unroll
            for (int j = 0; j < 8; ++j) { const float cs = j < 4 ? c0[j & 3] : c1[j & 3], sn = j < 4 ? s0[j & 3] : s1[j & 3];
                o1[j] = (lo[j] * cs - hi[j] * sn) * sc; o2[j] = (hi[j] * cs + lo[j] * sn) * sc; }
            bf16_t* dst = (seg == 4 ? Qa : Ka) + (size_t)row * 1024 + head * 128 + d0;
            u32x4 w1 = {pk2(o1[0], o1[1]), pk2(o1[2], o1[3]), pk2(o1[4], o1[5]), pk2(o1[6], o1[7])}, w2 = {pk2(o2[0], o2[1]), pk2(o2[2], o2[3]), pk2(o2[4], o2[5]), pk2(o2[6], o2[7])};
            *(u32x4*)dst = w1; *(u32x4*)(dst + 64) = w2;
            return;
        }
#pragma unroll
        for (int h = 0; h < 2; ++h) {
            const int col = 256 * pt + 128 * h + c; float v[8];
#pragma unroll
            for (int j = 0; j < 8; ++j) v[j] = h ? hi[j] : lo[j];
            if (seg == 1) {
                float* dst = Logf + (size_t)row * 1024 + col;
                const f32x4 l0 = *(const f32x4*)(lbv + col), l1 = *(const f32x4*)(lbv + col + 4);
                f32x4 r0, r1;
#pragma unroll
                for (int j = 0; j < 8; ++j) { const float lb = j < 4 ? l0[j & 3] : l1[j & 3]; const float f = lb + (1.f - lb) * sigmoidf_(v[j]); if (j < 4) r0[j & 3] = __log2f(f); else r1[j & 3] = __log2f(f); }
                *(f32x4*)dst = r0; *(f32x4*)(dst + 4) = r1;
            } else {
                if (seg == 0) {
#pragma unroll
                    for (int j = 0; j < 8; ++j) v[j] = v[j] * sigmoidf_(v[j]) * QSCALE;
                } else if (seg == 3) {
#pragma unroll
                    for (int j = 0; j < 8; ++j) v[j] = sigmoidf_(v[j]);
                }
                bf16_t* dst = (seg == 0 ? Qh : seg == 2 ? Vh : seg == 3 ? Gh : Va) + (size_t)row * 1024 + col;
                u32x4 w = {pk2(v[0], v[1]), pk2(v[2], v[3]), pk2(v[4], v[5]), pk2(v[6], v[7])};
                *(u32x4*)dst = w;
            }
        }
    }
};
struct EpiRes {
    const float* res; const float* gate; float* out;
    __device__ __forceinline__ void operator()(int row, int pn, int c, const float (&lo)[8], const float (&hi)[8]) const {
        const int b = row / S;
#pragma unroll
        for (int h = 0; h < 2; ++h) { const size_t col = 256 * pn + 128 * h + c; const size_t o = (size_t)row * D + col;
            const f32x4 r0 = *(const f32x4*)(res + o), r1 = *(const f32x4*)(res + o + 4), g0 = *(const f32x4*)(gate + (size_t)b * 6 * D + col), g1 = *(const f32x4*)(gate + (size_t)b * 6 * D + col + 4);
            f32x4 v0, v1;
#pragma unroll
            for (int j = 0; j < 4; ++j) { v0[j] = h ? hi[j] : lo[j]; v1[j] = h ? hi[4 + j] : lo[4 + j]; }
            *(f32x4*)(out + o) = r0 * ALPHA + g0 * v0; *(f32x4*)(out + o + 4) = r1 * ALPHA + g1 * v1; }
    }
};
struct EpiSwiglu {
    bf16_t* Hff;
    __device__ __forceinline__ void operator()(int row, int pn, int c, const float (&lo)[8], const float (&hi)[8]) const {
        float v[8];
#pragma unroll
        for (int j = 0; j < 8; ++j) v[j] = lo[j] * sigmoidf_(lo[j]) * hi[j];
        u32x4 w = {pk2(v[0], v[1]), pk2(v[2], v[3]), pk2(v[4], v[5]), pk2(v[6], v[7])};
        *(u32x4*)(Hff + (size_t)row * DFF + 128 * pn + c) = w;
    }
};

__device__ __forceinline__ int src_col_win(int n) {
    const int pn = n >> 8, t = n & 255, seg = pn >> 2, pt = pn & 3;
    if (seg == 4 || seg == 5) { const int bj = t >> 7, o = t & 127; return seg * 1024 + (2 * pt + (o >> 6)) * 128 + (o & 63) + 64 * bj; }
    return n;
}
__device__ __forceinline__ void transpose_item(const float* Wsrc, int ldw, bf16_t* WTrow, int K, int k0, LAS float* scr, int lane) {
#pragma unroll 8
    for (int i = 0; i < 32; ++i) { const int kk = 2 * i + (lane >> 5); scr[kk * 33 + (lane & 31)] = Wsrc[(size_t)(k0 + kk) * ldw + (lane & 31)]; }
    asm volatile("s_waitcnt lgkmcnt(0)" ::: "memory");
    const int c = lane & 7;
#pragma unroll
    for (int j = 0; j < 4; ++j) { const int n = (lane >> 3) + 8 * j; const LAS float* s = scr + (8 * c) * 33 + n;
        u32x4 o; o.x = pk2(s[0 * 33], s[1 * 33]); o.y = pk2(s[2 * 33], s[3 * 33]); o.z = pk2(s[4 * 33], s[5 * 33]); o.w = pk2(s[6 * 33], s[7 * 33]);
        *(u32x4*)(WTrow + (size_t)n * K + k0 + 8 * c) = o; }
    asm volatile("s_waitcnt lgkmcnt(0)" ::: "memory");
}
__device__ __forceinline__ void p0_prologue(const Ptrs& P, LAS unsigned char* lds, int tid, int lane, int wave) {
    {
        LAS float* cond = (LAS float*)lds;
        LAS float* part = (LAS float*)(lds + 32768);
        for (int i = tid; i < NB * D; i += NTHREADS) { const float v = P.c[i]; cond[i] = v / (1.f + __expf(-v)); }
        __syncthreads();
        for (int chunk = blockIdx.x; chunk < 6 * D / 48; chunk += gridDim.x) {
            const int col = tid % 48, ks = tid / 48, e = chunk * 48 + col;
            if (tid < 480) {
                float a0 = 0, a1 = 0, a2 = 0, a3 = 0;
#pragma unroll 8
                for (int k = ks; k < D; k += 10) { const float w = P.w_ada[(size_t)k * (6 * D) + e]; a0 += cond[k] * w; a1 += cond[D + k] * w; a2 += cond[2 * D + k] * w; a3 += cond[3 * D + k] * w; }
                LAS float* pp = part + (ks * 48 + col) * 4; pp[0] = a0; pp[1] = a1; pp[2] = a2; pp[3] = a3;
            }
            __syncthreads();
            if (tid < 192) { const int cc = tid % 48, b = tid / 48; float s = P.b_ada[chunk * 48 + cc];
#pragma unroll
                for (int q = 0; q < 10; ++q) s += part[(q * 48 + cc) * 4 + b];
                P.mod[(size_t)b * 6 * D + chunk * 48 + cc] = s; }
            __syncthreads();
        }
    }
    for (int gid = blockIdx.x * NTHREADS + tid; gid < M * 64; gid += gridDim.x * NTHREADS) {
        const int row = gid >> 6, i = gid & 63;
        const double inv = exp2(-(double)i * (13.287712379549449 / 64.0));
        const double rev = (double)P.positions[row] * inv * 0.15915494309189535;
        const float fr = (float)(rev - rint(rev));
        P.cosT[gid] = __builtin_amdgcn_cosf(fr); P.sinT[gid] = __builtin_amdgcn_sinf(fr);
    }
    if (blockIdx.x == 0) {
        for (int i = tid; i < 1024; i += NTHREADS) P.lbv[i] = 1.f / (1.f + __expf(P.lb_logits[1024 + i] - P.lb_logits[i]));
        if (tid == 0) { float s1 = 0, s2 = 0; for (int i = 0; i < 128; ++i) { s1 += P.lq1[i] * P.lk1[i]; s2 += P.lq2[i] * P.lk2[i]; } P.lam[0] = expf(s1) - expf(s2) + LAMBDA_INIT; }
    }
    {
        LAS float* scr = (LAS float*)(lds + wave * 16384);
        const int gw = blockIdx.x * NWAVES + wave, NGW = gridDim.x * NWAVES;
        constexpr int I_IN = (D / 64) * (NIN / 32), I_O = (D / 64) * (D / 32), I_GU = (D / 64) * (NGU / 32), I_D = (DFF / 64) * (D / 32);
        for (int it = gw; it < I_IN + I_O + I_GU + I_D; it += NGW) {
            int r = it;
            if (r < I_IN) { const int nb = r % (NIN / 32), kb = r / (NIN / 32), n0 = nb * 32; transpose_item(P.w_in + src_col_win(n0), NIN, P.WinT + (size_t)n0 * D, D, kb * 64, scr, lane); continue; } r -= I_IN;
            if (r < I_O) { const int nb = r % (D / 32), kb = r / (D / 32), n0 = nb * 32; transpose_item(P.w_out + n0, D, P.WoT + (size_t)n0 * D, D, kb * 64, scr, lane); continue; } r -= I_O;
            if (r < I_GU) { const int nb = r % (NGU / 32), kb = r / (NGU / 32), n0 = nb * 32, pn = n0 >> 8, t = n0 & 255;
                const float* src = (t < 128) ? P.w_gate + 128 * pn + t : P.w_up + 128 * pn + (t - 128);
                transpose_item(src, DFF, P.WguT + (size_t)n0 * D, D, kb * 64, scr, lane); continue; } r -= I_GU;
            { const int nb = r % (D / 32), kb = r / (D / 32), n0 = nb * 32; transpose_item(P.w_down + n0, D, P.WdT + (size_t)n0 * DFF, DFF, kb * 64, scr, lane); }
        }
    }
}

__device__ __forceinline__ void ln_stats(const f32x4 (&v)[8], float& mean, float& rstd) {
    float s = 0;
#pragma unroll
    for (int j = 0; j < 8; ++j) s += (v[j][0] + v[j][1]) + (v[j][2] + v[j][3]);
    mean = wave_sum(s) * (1.f / D); float q = 0;
#pragma unroll
    for (int j = 0; j < 8; ++j) { const f32x4 d = v[j] - mean; q += (d[0] * d[0] + d[1] * d[1]) + (d[2] * d[2] + d[3] * d[3]); }
    rstd = rsqrtf(wave_sum(q) * (1.f / D) + LN_EPS);
}
__device__ __forceinline__ void mod_store_bf16(const f32x4 (&v)[8], float mean, float rstd, const float* sc, const float* sh, bf16_t* dst, int lane) {
#pragma unroll
    for (int j = 0; j < 8; ++j) { const int col = 4 * lane + 256 * j; const f32x4 o = (v[j] - mean) * rstd * (*(const f32x4*)(sc + col) + 1.f) + *(const f32x4*)(sh + col);
        uint2 w; w.x = pk2(o[0], o[1]); w.y = pk2(o[2], o[3]); *(uint2*)(dst + col) = w; }
}
__device__ __forceinline__ void p1_ln_mod(const Ptrs& P, int lane, int wave) {
    for (int row = blockIdx.x * NWAVES + wave; row < M; row += gridDim.x * NWAVES) {
        const f32x4* xr = (const f32x4*)(P.x + (size_t)row * D) + lane; f32x4 v[8];
#pragma unroll
        for (int j = 0; j < 8; ++j) v[j] = xr[64 * j];
        float mean, rstd; ln_stats(v, mean, rstd);
        const float* mb = P.mod + (size_t)(row / S) * 6 * D;
        mod_store_bf16(v, mean, rstd, mb + D, mb, P.U + (size_t)row * D, lane);
    }
}
__device__ __forceinline__ void p5_ln1(const Ptrs& P, int lane, int wave) {
    for (int row = blockIdx.x * NWAVES + wave; row < M; row += gridDim.x * NWAVES) {
        const f32x4* xr = (const f32x4*)(P.T1 + (size_t)row * D) + lane; f32x4 v[8];
#pragma unroll
        for (int j = 0; j < 8; ++j) v[j] = xr[64 * j];
        float mean, rstd; ln_stats(v, mean, rstd);
#pragma unroll
        for (int j = 0; j < 8; ++j) { const int col = 4 * lane + 256 * j; v[j] = (v[j] - mean) * rstd * *(const f32x4*)(P.ln1_g + col) + *(const f32x4*)(P.ln1_b + col);
            *(f32x4*)(P.H1 + (size_t)row * D + col) = v[j]; }
        ln_stats(v, mean, rstd);
        const float* mb = P.mod + (size_t)(row / S) * 6 * D;
        mod_store_bf16(v, mean, rstd, mb + 4 * D, mb + 3 * D, P.U + (size_t)row * D, lane);
    }
}
__device__ __forceinline__ void p8_ln_final(const Ptrs& P, int lane, int wave) {
    for (int row = blockIdx.x * NWAVES + wave; row < M; row += gridDim.x * NWAVES) {
        f32x4* xr = (f32x4*)(P.out + (size_t)row * D) + lane; f32x4 v[8];
#pragma unroll
        for (int j = 0; j < 8; ++j) v[j] = xr[64 * j];
        float mean, rstd; ln_stats(v, mean, rstd);
#pragma unroll
        for (int j = 0; j < 8; ++j) { const int col = 4 * lane + 256 * j; xr[64 * j] = (v[j] - mean) * rstd * *(const f32x4*)(P.ln2_g + col) + *(const f32x4*)(P.ln2_b + col); }
    }
}

__device__ __forceinline__ void hgrn_simple_item(const Ptrs& P, int item, unsigned char* lds, int tid) {
    float* sf = (float*)lds; float* sk = sf + 128; float* sq = sk + 128; float* po = sq + 128  ; float* red = po + 512;
    const int b = item >> 3, h = item & 7, v = tid & 127, qd = tid >> 7;
    float St[32];
#pragma unroll
    for (int d = 0; d < 32; ++d) St[d] = 0.f;
    const float w = P.hg_norm_w[v];
    for (int t = 0; t < S; ++t) {
        const size_t off = (size_t)(b * S + t) * 1024 + h * 128 + v;
        if (qd == 0) { const float f = exp2f(P.Logf[off]); sf[v] = f; sk[v] = 1.f - f; sq[v] = bf2f(P.Qh[off]); }
        const float vv = bf2f(P.Vh[off]);
        __syncthreads();
        float o = 0.f;
#pragma unroll
        for (int d = 0; d < 32; ++d) { const int dd = qd * 32 + d; St[d] = sf[dd] * St[d] + sk[dd] * vv; o += St[d] * sq[dd]; }
        po[qd * 128 + v] = o;
        __syncthreads();
        if (qd == 0) { o = (po[v] + po[128 + v]) + (po[256 + v] + po[384 + v]); const float ss = wave_sum(o * o); if ((tid & 63) == 0) red[tid >> 6] = ss; }
        __syncthreads();
        if (qd == 0) { const float tot = red[0] + red[1]; const float gg = bf2f(P.Gh[off]);
            P.MIX[(size_t)(b * S + t) * D + h * 128 + v] = f2bf(o * rsqrtf(tot * (1.f / 128.f) + RMS_EPS) * w * gg); }
    }
    __syncthreads();
}

typedef short s16x4 __attribute__((ext_vector_type(4)));
typedef unsigned u32x2 __attribute__((ext_vector_type(2)));
typedef float f32x2_t __attribute__((ext_vector_type(2))); typedef __bf16 bf16x2_t __attribute__((ext_vector_type(2)));
__device__ __forceinline__ unsigned cvtpk_s(float lo, float hi) { f32x2_t v = {lo, hi}; bf16x2_t b = __builtin_convertvector(v, bf16x2_t); return __builtin_bit_cast(unsigned, b); }
__device__ __forceinline__ float ex2(float x) { return __builtin_amdgcn_exp2f(x); }
namespace hg {
constexpr int SETB = 49664, O_QT = 0, O_KT = 8704, O_QD = 17408, O_KDT = 26112, O_VT = 36352, O_XT = 46592, O_DL = 49152, O_TT = 2 * SETB, O_RED = 0;
constexpr size_t OUT_QCUM = 64 * MiB, OUT_SLOC = 96 * MiB, OUT_GTOT = 112 * MiB;
}
#define HG_MFMA(a, b, c) __builtin_amdgcn_mfma_f32_16x16x32_bf16((a), (b), (c), 0, 0, 0)
__device__ __forceinline__ void hgrn_local_item(const Ptrs& P, int item, LAS unsigned char* lds, int tid, int lane, int wave) {
    using namespace hg;
    const int b = item >> 6, h = (item >> 3) & 7, seg = item & 7;
    const int d = tid & 127, tg = tid >> 7, fr = lane & 15, fq = lane >> 4;
    const size_t row00 = (size_t)b * S + (size_t)seg * 512;
    const int colh = h * 128;
    float* Oloc = P.out; bf16_t* Qcum = (bf16_t*)((unsigned char*)P.out + OUT_QCUM); float* Sloc = (float*)((unsigned char*)P.out + OUT_SLOC); float* Gtot = (float*)((unsigned char*)P.out + OUT_GTOT);
    f32x4 sacc[8];
#pragma unroll
    for (int kb = 0; kb < 8; ++kb) sacc[kb] = (f32x4){0.f, 0.f, 0.f, 0.f};
    float Gseg = 0.f;
    float Lr[8]; bf16_t qr[8], vr[8];
    {   const size_t o = (row00 + 8 * tg) * 1024 + colh + d;
#pragma unroll
        for (int i = 0; i < 8; ++i) { Lr[i] = P.Logf[o + (size_t)i * 1024]; qr[i] = P.Qh[o + (size_t)i * 1024]; vr[i] = P.Vh[o + (size_t)i * 1024]; } }
    LAS float* TT = (LAS float*)(lds + O_TT);
    for (int n = 0; n < 16; ++n) {
        LAS unsigned char* sb = lds + (n & 1) * SETB;
        const size_t row0 = row00 + (size_t)n * 32;
        float g[8]; g[0] = Lr[0];
#pragma unroll
        for (int i = 1; i < 8; ++i) g[i] = g[i - 1] + Lr[i];
        TT[tg * 128 + d] = g[7];
        __syncthreads();
        {
            const float t0 = TT[d], t1 = TT[128 + d], t2 = TT[256 + d], t3 = TT[384 + d];
            const float pre = tg == 0 ? 0.f : tg == 1 ? t0 : tg == 2 ? t0 + t1 : (t0 + t1) + t2;
            const float Gref = t0 + t1, Glast = (t0 + t1) + (t2 + t3);
            const float eRef = ex2(Gref), eLR = ex2(Glast - Gref), eSeg = ex2(Gseg);
            float kd[8];
#pragma unroll
            for (int i = 0; i < 8; ++i) {
                const int t = 8 * tg + i; const float G = pre + g[i];
                const float kk = 1.f - ex2(Lr[i]), e1 = ex2(G - Gref), e2 = __builtin_amdgcn_rcpf(e1);
                const float qt = bf2f(qr[i]) * e1, kt = kk * e2, qd = qt * eRef;
                kd[i] = kt * eLR;
                *(LAS bf16_t*)(sb + O_QT + t * 272 + d * 2) = (bf16_t)cvtpk_s(qt, 0.f);
                *(LAS bf16_t*)(sb + O_KT + t * 272 + d * 2) = (bf16_t)cvtpk_s(kt, 0.f);
                *(LAS bf16_t*)(sb + O_QD + t * 272 + d * 2) = (bf16_t)cvtpk_s(qd, 0.f);
                Qcum[(row0 + t) * 1024 + colh + d] = (bf16_t)cvtpk_s(qd * eSeg, 0.f);
            }
            u32x4 kw = {cvtpk_s(kd[0], kd[1]), cvtpk_s(kd[2], kd[3]), cvtpk_s(kd[4], kd[5]), cvtpk_s(kd[6], kd[7])};
            u32x4 vw = {(unsigned)vr[0] | ((unsigned)vr[1] << 16), (unsigned)vr[2] | ((unsigned)vr[3] << 16), (unsigned)vr[4] | ((unsigned)vr[5] << 16), (unsigned)vr[6] | ((unsigned)vr[7] << 16)};
            *(LAS u32x4*)(sb + O_KDT + d * 80 + tg * 16) = kw;
            *(LAS u32x4*)(sb + O_VT + d * 80 + tg * 16) = vw;
            if (tg == 0) *(LAS float*)(sb + O_DL + d * 4) = ex2(Glast);
            Gseg += Glast;
        }
        if (n + 1 < 16) {
            const size_t o = (row0 + 32 + 8 * tg) * 1024 + colh + d;
#pragma unroll
            for (int i = 0; i < 8; ++i) { Lr[i] = P.Logf[o + (size_t)i * 1024]; qr[i] = P.Qh[o + (size_t)i * 1024]; vr[i] = P.Vh[o + (size_t)i * 1024]; }
        }
        __syncthreads();
        if (wave < 4) {
            const int jb = wave >> 1, ib = wave & 1;
            f32x4 xa = (f32x4){0.f, 0.f, 0.f, 0.f};
            if (!(jb == 1 && ib == 0)) {
#pragma unroll
                for (int s = 0; s < 4; ++s) {
                    const bf16x8 af = *(const LAS bf16x8*)(sb + O_KT + (16 * jb + fr) * 272 + 64 * s + 16 * fq);
                    const bf16x8 bf = *(const LAS bf16x8*)(sb + O_QT + (16 * ib + fr) * 272 + 64 * s + 16 * fq);
                    xa = HG_MFMA(af, bf, xa);
                }
            }
            const int i = 16 * ib + fr, j0 = 16 * jb + 4 * fq;
            u32x2 w; w.x = cvtpk_s(j0 <= i ? xa[0] : 0.f, j0 + 1 <= i ? xa[1] : 0.f); w.y = cvtpk_s(j0 + 2 <= i ? xa[2] : 0.f, j0 + 3 <= i ? xa[3] : 0.f);
            *(LAS u32x2*)(sb + O_XT + i * 80 + 32 * jb + 8 * fq) = w;
        }
        f32x4 oacc[2] = {(f32x4){0.f, 0.f, 0.f, 0.f}, (f32x4){0.f, 0.f, 0.f, 0.f}};
#pragma unroll
        for (int s = 0; s < 4; ++s) {
            const u32x4 aw = {cvtpk_s(sacc[2 * s][0], sacc[2 * s][1]), cvtpk_s(sacc[2 * s][2], sacc[2 * s][3]), cvtpk_s(sacc[2 * s + 1][0], sacc[2 * s + 1][1]), cvtpk_s(sacc[2 * s + 1][2], sacc[2 * s + 1][3])};
            const bf16x8 af = __builtin_bit_cast(bf16x8, aw);
#pragma unroll
            for (int ib = 0; ib < 2; ++ib) {
                const LAS unsigned char* qp = sb + O_QD + (16 * ib + fr) * 272 + 64 * s + 8 * fq;
                const s16x4 lo = *(const LAS s16x4*)qp, hi = *(const LAS s16x4*)(qp + 32);
                const bf16x8 bf = __builtin_shufflevector(lo, hi, 0, 1, 2, 3, 4, 5, 6, 7);
                oacc[ib] = HG_MFMA(af, bf, oacc[ib]);
            }
        }
        const bf16x8 vf = *(const LAS bf16x8*)(sb + O_VT + (16 * wave + fr) * 80 + 16 * fq);
#pragma unroll
        for (int kb = 0; kb < 8; ++kb) {
            const f32x4 dl = *(const LAS f32x4*)(sb + O_DL + (16 * kb + 4 * fq) * 4);
            const bf16x8 af = *(const LAS bf16x8*)(sb + O_KDT + (16 * kb + fr) * 80 + 16 * fq);
            sacc[kb] = HG_MFMA(af, vf, sacc[kb] * dl);
        }
        __syncthreads();
#pragma unroll
        for (int ib = 0; ib < 2; ++ib) {
            const bf16x8 xf = *(const LAS bf16x8*)(sb + O_XT + (16 * ib + fr) * 80 + 16 * fq);
            oacc[ib] = HG_MFMA(vf, xf, oacc[ib]);
            *(f32x4*)(Oloc + (row0 + 16 * ib + fr) * 1024 + colh + 16 * wave + 4 * fq) = oacc[ib];
        }
    }
#pragma unroll
    for (int kb = 0; kb < 8; ++kb) *(f32x4*)(Sloc + ((((size_t)item * 8 + wave) * 8 + kb) * 64 + lane) * 4) = sacc[kb];
    if (tg == 0) Gtot[item * 128 + d] = Gseg;
    __syncthreads();
}
__device__ __forceinline__ void hgrn_fix_item(const Ptrs& P, int item, LAS unsigned char* lds, int lane, int wave) {
    using namespace hg;
    const int b = item >> 6, h = (item >> 3) & 7, seg = item & 7, fr = lane & 15, fq = lane >> 4;
    const size_t row00 = (size_t)b * S + (size_t)seg * 512;
    const int colw = h * 128 + 16 * wave + 4 * fq;
    const float* Oloc = P.out; const bf16_t* Qcum = (const bf16_t*)((const unsigned char*)P.out + OUT_QCUM); const float* Sloc = (const float*)((const unsigned char*)P.out + OUT_SLOC); const float* Gtot = (const float*)((const unsigned char*)P.out + OUT_GTOT);
    f32x4 sacc[8];
#pragma unroll
    for (int kb = 0; kb < 8; ++kb) sacc[kb] = (f32x4){0.f, 0.f, 0.f, 0.f};
    for (int sp = 0; sp < seg; ++sp) {
        const int itp = item - seg + sp;
#pragma unroll
        for (int kb = 0; kb < 8; ++kb) {
            const f32x4 gl = *(const f32x4*)(Gtot + itp * 128 + 16 * kb + 4 * fq);
            const f32x4 sl = *(const f32x4*)(Sloc + ((((size_t)itp * 8 + wave) * 8 + kb) * 64 + lane) * 4);
            f32x4 dl; dl[0] = ex2(gl[0]); dl[1] = ex2(gl[1]); dl[2] = ex2(gl[2]); dl[3] = ex2(gl[3]);
            sacc[kb] = sacc[kb] * dl + sl;
        }
    }
    bf16x8 af[4];
#pragma unroll
    for (int s = 0; s < 4; ++s) { const u32x4 aw = {cvtpk_s(sacc[2 * s][0], sacc[2 * s][1]), cvtpk_s(sacc[2 * s][2], sacc[2 * s][3]), cvtpk_s(sacc[2 * s + 1][0], sacc[2 * s + 1][1]), cvtpk_s(sacc[2 * s + 1][2], sacc[2 * s + 1][3])};
        af[s] = __builtin_bit_cast(bf16x8, aw); }
    const f32x4 nw = *(const f32x4*)(P.hg_norm_w + 16 * wave + 4 * fq);
    LAS float* red = (LAS float*)(lds + O_RED);
    for (int n = 0; n < 16; ++n) {
        f32x4 o[2];
#pragma unroll
        for (int ib = 0; ib < 2; ++ib) {
            const size_t row = row00 + (size_t)n * 32 + 16 * ib + fr;
            f32x4 acc = *(const f32x4*)(Oloc + row * 1024 + colw);
            if (seg > 0) {
#pragma unroll
                for (int s = 0; s < 4; ++s) {
                    const bf16_t* qp = Qcum + row * 1024 + h * 128 + 32 * s + 4 * fq;
                    const s16x4 lo = *(const s16x4*)qp, hi = *(const s16x4*)(qp + 16);
                    acc = HG_MFMA(af[s], __builtin_shufflevector(lo, hi, 0, 1, 2, 3, 4, 5, 6, 7), acc);
                }
            }
            float ss = (acc[0] * acc[0] + acc[1] * acc[1]) + (acc[2] * acc[2] + acc[3] * acc[3]);
            ss += __shfl_xor(ss, 16); ss += __shfl_xor(ss, 32);
            if (fq == 0) red[((n & 1) * 8 + wave) * 32 + 16 * ib + fr] = ss;
            o[ib] = acc;
        }
        __syncthreads();
#pragma unroll
        for (int ib = 0; ib < 2; ++ib) {
            const size_t row = row00 + (size_t)n * 32 + 16 * ib + fr;
            float tot = 0.f;
#pragma unroll
            for (int w = 0; w < 8; ++w) tot += red[((n & 1) * 8 + w) * 32 + 16 * ib + fr];
            const float rs = rsqrtf(tot * (1.f / 128.f) + RMS_EPS);
            const uint2 gg = *(const uint2*)(P.Gh + row * 1024 + colw);
            const f32x4 y = o[ib] * rs * nw;
            uint2 ow; ow.x = pk2(y[0] * __uint_as_float(gg.x << 16), y[1] * __uint_as_float(gg.x & 0xffff0000u)); ow.y = pk2(y[2] * __uint_as_float(gg.y << 16), y[3] * __uint_as_float(gg.y & 0xffff0000u));
            *(uint2*)(P.MIX + row * D + colw) = ow;
        }
    }
    __syncthreads();
}

typedef attn::BlockRef<attn::bf16, attn::bf16> ARef;
__device__ __forceinline__ ARef attn_ref(const Ptrs& P, int L, int pass) {
    const int x = L & 7, k = (L >> 3) & 31, rd = L >> 8, g = x * 4 + rd * 2 + (k >> 4), b = g >> 3, hh = g & 7, idx = k & 15, vh = idx & 1, pair = idx >> 1;
    const int qb = pass ? 15 - pair : pair;
    ARef r; const size_t row0 = (size_t)b * S + (size_t)qb * 256;
    r.Q = (const attn::bf16*)P.Qa + row0 * 1024 + hh * 128;
    r.K = (const attn::bf16*)P.Ka + (size_t)b * S * 1024 + hh * 128;
    r.V = (const attn::bf16*)P.Va + (size_t)b * S * 1024 + (hh >> 1) * 256 + vh * 128;
    r.O = (attn::bf16*)((hh & 1) ? P.O2 : P.O1) + row0 * 1024 + (hh >> 1) * 256 + vh * 128;
    r.P0 = qb * 256;
    return r;
}
__device__ __forceinline__ void p3_attention(const Ptrs& P, unsigned char* lds, const int tid) {
    const int G = gridDim.x, bid = blockIdx.x;
    if (bid >= 512) return;
    const int nblk = 2 * ((512 - bid + G - 1) / G);
    ARef cur = attn_ref(P, bid, 0);
    attn::Seam<attn::bf16> Sm;
    attn::causal_swa_prime<attn::bf16, attn::bf16>(cur, S, (char*)lds, Sm, tid);
    for (int q = 0; q < nblk; ++q) {
        const bool last = (q + 1 == nblk);
        const ARef nxt = last ? cur : attn_ref(P, bid + ((q + 1) >> 1) * G, (q + 1) & 1);
        attn::causal_swa_block<attn::bf16, attn::bf16>(cur, nxt, S, S, (char*)lds, Sm, tid);
        cur = nxt;
    }
}
__device__ __forceinline__ void p4_attn_combine(const Ptrs& P, int lane, int wave) {
    const float lam = P.lam[0];
    const f32x4 w = *(const f32x4*)(P.subln_w + 4 * lane);
    for (int row = blockIdx.x * NWAVES + wave; row < M; row += gridDim.x * NWAVES) {
#pragma unroll
        for (int h = 0; h < 4; ++h) {
            const uint2 a = *(const uint2*)(P.O1 + (size_t)row * 1024 + h * 256 + 4 * lane), b2 = *(const uint2*)(P.O2 + (size_t)row * 1024 + h * 256 + 4 * lane);
            float y[4];
            y[0] = __uint_as_float(a.x << 16) - lam * __uint_as_float(b2.x << 16); y[1] = __uint_as_float(a.x & 0xffff0000u) - lam * __uint_as_float(b2.x & 0xffff0000u);
            y[2] = __uint_as_float(a.y << 16) - lam * __uint_as_float(b2.y << 16); y[3] = __uint_as_float(a.y & 0xffff0000u) - lam * __uint_as_float(b2.y & 0xffff0000u);
            const float ss = wave_sum((y[0] * y[0] + y[1] * y[1]) + (y[2] * y[2] + y[3] * y[3]));
            const float rs = rsqrtf(ss * (1.f / 256.f) + RMS_EPS) * (1.f - LAMBDA_INIT);
            uint2 o; o.x = pk2(y[0] * rs * w[0], y[1] * rs * w[1]); o.y = pk2(y[2] * rs * w[2], y[3] * rs * w[3]);
            *(uint2*)(P.MIX + (size_t)row * D + 1024 + h * 256 + 4 * lane) = o;
        }
    }
}
__device__ __forceinline__ void p3_mixers(const Ptrs& P, unsigned char* lds, int tid, int lane, int wave) {
    for (int it = blockIdx.x; it < 256; it += gridDim.x) hgrn_local_item(P, it, (LAS unsigned char*)lds, tid, lane, wave);
    p3_attention(P, lds, tid);
}


#define XB_TMO      128
#define XB_XCNT(j)  (256  + 64 * (j))
#define XB_XSUB(j)  (1280 + 64 * (j))
#define XB_XGEN(j)  (2304 + 64 * (j))
#define XB_TOP      3328
#define XB_TOPGEN   3392
#define XCD_BAR_WORDS 3456
#define XB_SPIN_CAP (1u << 18)
__device__ __forceinline__ unsigned xb_ld(unsigned* p)              { return __hip_atomic_load(p, __ATOMIC_RELAXED, __HIP_MEMORY_SCOPE_AGENT); }
__device__ __forceinline__ unsigned xb_add(unsigned* p, unsigned v) { return __hip_atomic_fetch_add(p, v, __ATOMIC_RELAXED, __HIP_MEMORY_SCOPE_AGENT); }
__device__ __forceinline__ unsigned xb_xcc_id() { return (unsigned)__builtin_amdgcn_s_getreg((3 << 11) | 20) & 0xFu; }
#define XB_SPIN(cond, bar) do { unsigned _sp = 0; while (cond) { __builtin_amdgcn_s_sleep(1); \
    if ((++_sp & 255u) == 0u) { if (xb_ld(&(bar)[XB_TMO])) break; if (_sp > XB_SPIN_CAP) { atomicAdd(&(bar)[XB_TMO], 1u); break; } } } } while (0)
__device__ __forceinline__ void xcd_barrier_post(unsigned* bar, int tid) { if (tid == 0) (void)xb_add(&bar[XB_XCNT(xb_xcc_id())], 1u); }
__device__ __forceinline__ void xcd_barrier_complete(unsigned* bar, unsigned x, unsigned& nloc, unsigned& nx) {
    const unsigned G = gridDim.x * gridDim.y * gridDim.z;
    unsigned sum, cnt, mine, sp = 0u;
    for (;;) {
        sum = 0u; cnt = 0u; mine = 0u;
#pragma unroll
        for (unsigned j = 0; j < 16; ++j) { const unsigned c = xb_ld(&bar[XB_XCNT(j)]); sum += c; cnt += (c > 0u) ? 1u : 0u; mine = (j == x) ? c : mine; }
        if (sum == G) break;
        __builtin_amdgcn_s_sleep(1);
        if ((++sp & 255u) == 0u) { if (xb_ld(&bar[XB_TMO])) break; if (sp > XB_SPIN_CAP) { atomicAdd(&bar[XB_TMO], 1u); break; } }
    }
    nloc = mine > 0u ? mine : 1u; nx = cnt > 0u ? cnt : 1u;
}
__device__ __forceinline__ void xcd_barrier(unsigned* bar, volatile LAS unsigned* st, int tid) {
    asm volatile("s_waitcnt vmcnt(0)" ::: "memory");
    __syncthreads();
    if (tid == 0) {
        const unsigned x = xb_xcc_id();
        __builtin_amdgcn_s_waitcnt(0);
        unsigned nloc = st[0], nx = st[1];
        if (nloc == 0u) { xcd_barrier_complete(bar, x, nloc, nx); st[0] = nloc; st[1] = nx; }
        const unsigned old = xb_add(&bar[XB_XSUB(x)], 1u);
        const unsigned gen = old / nloc;
        if (old + 1u == (gen + 1u) * nloc) {
            __builtin_amdgcn_fence(__ATOMIC_RELEASE, "agent");
            asm volatile("s_waitcnt vmcnt(0)" ::: "memory");
            const unsigned og = xb_add(&bar[XB_TOP], 1u);
            const unsigned tg = og / nx;
            if (og + 1u == (tg + 1u) * nx) xb_add(&bar[XB_TOPGEN], 1u);
            else XB_SPIN(xb_ld(&bar[XB_TOPGEN]) == tg, bar);
            __builtin_amdgcn_fence(__ATOMIC_ACQUIRE, "agent");
            xb_add(&bar[XB_XGEN(x)], 1u);
            asm volatile("s_waitcnt vmcnt(0)" ::: "memory");
        } else {
            XB_SPIN(xb_ld(&bar[XB_XGEN(x)]) == gen, bar);
            __builtin_amdgcn_fence(__ATOMIC_ACQUIRE, "agent");
            asm volatile("s_waitcnt vmcnt(0)" ::: "memory");
        }
    }
    __syncthreads();
}

__device__ __forceinline__ int lane_id_asm() { int l; asm volatile("v_mbcnt_lo_u32_b32 %0, -1, 0\n\tv_mbcnt_hi_u32_b32 %0, -1, %0" : "=v"(l)); return l; }
struct Args { const void* in[21]; float* out; unsigned char* ws; int ph_lo, ph_hi; };
constexpr int NPHASE = 10;
__device__ __forceinline__ Ptrs mk_ptrs(const Args& a) {
    Ptrs P;
    P.x = (const float*)a.in[0]; P.c = (const float*)a.in[1]; P.positions = (const int*)a.in[2]; P.w_ada = (const float*)a.in[3]; P.b_ada = (const float*)a.in[4]; P.w_in = (const float*)a.in[5];
    P.lb_logits = (const float*)a.in[6]; P.hg_norm_w = (const float*)a.in[7]; P.lq1 = (const float*)a.in[8]; P.lk1 = (const float*)a.in[9]; P.lq2 = (const float*)a.in[10]; P.lk2 = (const float*)a.in[11];
    P.subln_w = (const float*)a.in[12]; P.w_out = (const float*)a.in[13]; P.ln1_g = (const float*)a.in[14]; P.ln1_b = (const float*)a.in[15]; P.w_gate = (const float*)a.in[16]; P.w_up = (const float*)a.in[17];
    P.w_down = (const float*)a.in[18]; P.ln2_g = (const float*)a.in[19]; P.ln2_b = (const float*)a.in[20];
    P.out = a.out; unsigned char* ws = a.ws;
    P.mod = (float*)(ws + OFF_MOD); P.lbv = (float*)(ws + OFF_LB); P.lam = (float*)(ws + OFF_LAM); P.cosT = (float*)(ws + OFF_COS); P.sinT = (float*)(ws + OFF_SIN);
    P.WinT = (bf16_t*)(ws + OFF_WIN); P.WoT = (bf16_t*)(ws + OFF_WO); P.WguT = (bf16_t*)(ws + OFF_WGU); P.WdT = (bf16_t*)(ws + OFF_WD);
    P.U = (bf16_t*)(ws + OFF_U); P.MIX = (bf16_t*)(ws + OFF_MIX); P.Qh = (bf16_t*)(ws + OFF_QH); P.Vh = (bf16_t*)(ws + OFF_VH); P.Gh = (bf16_t*)(ws + OFF_GH); P.Logf = (float*)(ws + OFF_LOGF);
    P.Qa = (bf16_t*)(ws + OFF_QA); P.Ka = (bf16_t*)(ws + OFF_KA); P.Va = (bf16_t*)(ws + OFF_VA); P.T1 = (float*)(ws + OFF_T1); P.H1 = (float*)(ws + OFF_H1); P.Hff = (bf16_t*)(ws + OFF_HFF); P.O1 = (bf16_t*)(ws + OFF_O1); P.O2 = (bf16_t*)(ws + OFF_O2);
    return P;
}
__global__ void __launch_bounds__(NTHREADS, 2) fwd_kernel(Args a) {
    extern __shared__ __attribute__((aligned(16))) unsigned char lds[];
    cg::grid_group grid = cg::this_grid();
    const int wave = __builtin_amdgcn_readfirstlane(threadIdx.x >> 6);
    LAS unsigned char* ldsl = (LAS unsigned char*)lds;
    volatile LAS unsigned* bst = (volatile LAS unsigned*)(ldsl + LDS_BYTES - 64);
    { const int l0 = lane_id_asm(); if (wave == 0 && l0 < 2) bst[l0] = 0u; }
    __syncthreads();
    const int lo = a.ph_lo, hi = a.ph_hi;
#define IN(k) (lo <= (k) && (k) < hi)
#define SEAM(k) do { if (IN(k) && IN((k) + 1)) { const int lane_ = lane_id_asm(); xcd_barrier((unsigned*)(a.ws + OFF_BAR), bst, wave * 64 + lane_); } } while (0)
    if (IN(0) && blockIdx.x == 0) { const int lane_ = lane_id_asm(); unsigned* bw = (unsigned*)(a.ws + OFF_BAR); for (int i = wave * 64 + lane_; i < XCD_BAR_WORDS; i += NTHREADS) bw[i] = 0u; }
    if (IN(0)) { const Ptrs P = mk_ptrs(a); const int lane = lane_id_asm(), tid = wave * 64 + lane; p0_prologue(P, ldsl, tid, lane, wave); }
    if (IN(0) && IN(1)) { grid.sync(); { const int lane_ = lane_id_asm(); xcd_barrier_post((unsigned*)(a.ws + OFF_BAR), wave * 64 + lane_); } }
    if (IN(1)) { const Ptrs P = mk_ptrs(a); const int lane = lane_id_asm(), tid = wave * 64 + lane; p1_ln_mod(P, lane, wave); } SEAM(1);
    if (IN(2)) { const Ptrs P = mk_ptrs(a); const int lane = lane_id_asm(), tid = wave * 64 + lane;
        pg8::Gemm g{P.U, P.WinT, M, NIN, D}; pg8::StaticOrder So; So.init(M, NIN, gridDim.x, blockIdx.x);
        pg8::EpiAdapt<Epi1> E{Epi1{P.Qh, P.Vh, P.Gh, P.Qa, P.Ka, P.Va, P.Logf, P.lbv, P.cosT, P.sinT}};
        pg8::gemm_phase<pg8::EpiAdapt<Epi1>, pg8::StaticOrder, true, true>(ldsl, g, So, E, tid);
    } SEAM(2);
    if (IN(3)) { const Ptrs P = mk_ptrs(a); const int lane = lane_id_asm(), tid = wave * 64 + lane; p3_mixers(P, lds, tid, lane, wave); } SEAM(3);
    if (IN(4)) { const Ptrs P = mk_ptrs(a); const int lane = lane_id_asm(), tid = wave * 64 + lane; for (int it = blockIdx.x; it < 256; it += gridDim.x) hgrn_fix_item(P, it, ldsl, lane, wave); p4_attn_combine(P, lane, wave); } SEAM(4);
    if (IN(5)) { const Ptrs P = mk_ptrs(a); const int lane = lane_id_asm(), tid = wave * 64 + lane;
        pg8::Gemm g{P.MIX, P.WoT, M, D, D}; pg8::StaticOrder So; So.init(M, D, gridDim.x, blockIdx.x);
        pg8::EpiAdapt<EpiRes> E{EpiRes{P.x, P.mod + 2 * D, P.T1}};
        pg8::gemm_phase<pg8::EpiAdapt<EpiRes>, pg8::StaticOrder, true, true>(ldsl, g, So, E, tid);
    } SEAM(5);
    if (IN(6)) { const Ptrs P = mk_ptrs(a); const int lane = lane_id_asm(), tid = wave * 64 + lane; p5_ln1(P, lane, wave); } SEAM(6);
    if (IN(7)) { const Ptrs P = mk_ptrs(a); const int lane = lane_id_asm(), tid = wave * 64 + lane;
        pg8::Gemm g{P.U, P.WguT, M, NGU, D}; pg8::StaticOrder So; So.init(M, NGU, gridDim.x, blockIdx.x);
        pg8::EpiAdapt<EpiSwiglu> E{EpiSwiglu{P.Hff}};
        pg8::gemm_phase<pg8::EpiAdapt<EpiSwiglu>, pg8::StaticOrder, true, true>(ldsl, g, So, E, tid);
    } SEAM(7);
    if (IN(8)) { const Ptrs P = mk_ptrs(a); const int lane = lane_id_asm(), tid = wave * 64 + lane;
        pg8::Gemm g{P.Hff, P.WdT, M, D, DFF}; pg8::StaticOrder So; So.init(M, D, gridDim.x, blockIdx.x);
        pg8::EpiAdapt<EpiRes> E{EpiRes{P.H1, P.mod + 5 * D, P.out}};
        pg8::gemm_phase<pg8::EpiAdapt<EpiRes>, pg8::StaticOrder, true, true>(ldsl, g, So, E, tid);
    } SEAM(8);
    if (IN(9)) { const Ptrs P = mk_ptrs(a); const int lane = lane_id_asm(), tid = wave * 64 + lane; p8_ln_final(P, lane, wave); }
#undef IN
#undef SEAM
}

#ifndef MK_N_LAUNCHES
#define MK_N_LAUNCHES 1
#endif
extern "C" void kernel_launch(void* const* d_in, const int* in_sizes, int n_in, void* d_out, int out_size, void* d_ws, size_t ws_size, hipStream_t stream) {
    static int grid = 0;
    if (grid == 0) {
        if (n_in != 21 || in_sizes[0] != M * D || out_size != M * D || ws_size < WS_NEED) { fprintf(stderr, "kernel_launch: unexpected shapes (n_in %d, in0 %d, out %d, ws %zu)\n", n_in, n_in > 0 ? in_sizes[0] : -1, out_size, ws_size); grid = -1; return; }
        int dev = 0, cus = 0, per_cu = 0;
        if (hipGetDevice(&dev) != hipSuccess || hipDeviceGetAttribute(&cus, hipDeviceAttributeMultiprocessorCount, dev) != hipSuccess) { fprintf(stderr, "kernel_launch: device query failed\n"); grid = -1; return; }
        if (hipFuncSetAttribute((const void*)fwd_kernel, hipFuncAttributeMaxDynamicSharedMemorySize, LDS_BYTES) != hipSuccess) { fprintf(stderr, "kernel_launch: hipFuncSetAttribute failed\n"); grid = -1; return; }
        if (hipOccupancyMaxActiveBlocksPerMultiprocessor(&per_cu, (const void*)fwd_kernel, NTHREADS, LDS_BYTES) != hipSuccess || per_cu < 1) { fprintf(stderr, "kernel_launch: occupancy query says %d blocks per CU\n", per_cu); (void)hipGetLastError(); per_cu = 1; }
        grid = cus * (per_cu < 1 ? 1 : 1);
    }
    if (grid < 0) return;
    Args a{};
    for (int i = 0; i < 21; ++i) a.in[i] = d_in[i];
    a.out = (float*)d_out; a.ws = (unsigned char*)d_ws;
#if MK_N_LAUNCHES == 1
    a.ph_lo = 0; a.ph_hi = NPHASE;
    void* args[] = {&a};
    hipError_t e = hipLaunchCooperativeKernel((const void*)fwd_kernel, dim3(grid), dim3(NTHREADS), args, LDS_BYTES, stream);
    if (e != hipSuccess) fprintf(stderr, "kernel_launch: cooperative launch failed: %s (grid %d)\n", hipGetErrorString(e), grid);
#else
    for (int p = 0; p < NPHASE; ++p) { a.ph_lo = p; a.ph_hi = p + 1; hipLaunchKernelGGL(fwd_kernel, dim3(grid), dim3(NTHREADS), LDS_BYTES, stream, a); }
#endif
}
```

```cpp
#include <hip/hip_runtime.h>
#include <hip/hip_cooperative_groups.h>
#include <hip/hip_bf16.h>
#include <stdint.h>
#include <cstdio>
namespace cg = cooperative_groups;
namespace pg8 {
#define PG8_LAS __attribute__((address_space(3)))
typedef unsigned short bf16_t;
typedef short bf16x8 __attribute__((ext_vector_type(8)));
typedef float f32x4 __attribute__((ext_vector_type(4)));
typedef unsigned u32x4 __attribute__((ext_vector_type(4)));
constexpr int BM = 256, BK = 64, HALF = 128, HTB = HALF * BK * 2  , STAGE_BYTES = 8 * HTB, NXCD = 8, WGM = 8;

__host__ __device__ __forceinline__ int lds_byte(int r, int c) { const int st = (r >> 4) * 2 + (c >> 5), rr = r & 15, cc = c & 31, ob = rr * 64 + cc * 2; return st * 1024 + (ob ^ (((ob >> 9) & 1) << 5)); }
__host__ __device__ __forceinline__ void stage_rc(int b, int& R, int& C) { const int st = b / 1024, sb = b % 1024, swz = sb ^ (((sb >> 9) & 1) << 5); R = (st >> 1) * 16 + swz / 64; C = (st & 1) * 32 + (swz % 64) / 2; }
__host__ __device__ __forceinline__ int perm32(int rho) { const int n = rho >> 4, i = rho & 15; return 8 * (i >> 2) + 4 * n + (i & 3); }

struct Unit { int pm, pn; };
struct Gemm { const bf16_t* A; const bf16_t* Bt; int M, N, K; };

struct StaticOrder {
    int nM, nN, nwg, G, c;
    __host__ __device__ void init(int M, int N, int G_, int c_) { nM = M / BM; nN = N / BM; nwg = nM * nN; G = G_; c = c_; }
    __host__ __device__ bool next(int i, Unit& u) const {
        const long L = (long)i * G + c; if (L >= nwg) return false;
        int wgid = (int)L; { const int q = nwg / NXCD, r = nwg % NXCD, xcd = wgid % NXCD, off = wgid / NXCD; wgid = (xcd < r ? xcd * (q + 1) : r * (q + 1) + (xcd - r) * q) + off; }
        const int nig = WGM * nN, gid = wgid / nig, fm = gid * WGM, gsz = (nM - fm) < WGM ? (nM - fm) : WGM;
        u.pm = fm + ((wgid % nig) % gsz); u.pn = (wgid % nig) / gsz; return true;
    }
    __device__ __forceinline__ void a_ready(const Unit&) const {}
    __device__ __forceinline__ void done(const Unit&) const {}
};
template <class Epi, class Sched, bool ALIGN_EPI = false, bool SP2 = false>
__device__ __forceinline__ void gemm_phase(PG8_LAS unsigned char* lds, const Gemm g, const Sched& S, const Epi& E, const int tid_in) {
    const int tid = tid_in, wid = __builtin_amdgcn_readfirstlane(tid >> 6), lane = tid & 63, wr = wid >> 2, wc = wid & 3, fr = lane & 15, fq = lane >> 4;
    const int K = g.K, nt = K / BK;
    unsigned voffA[2], voffB[2];
#pragma unroll
    for (int i = 0; i < 2; ++i) { int R, C; stage_rc(tid * 16 + i * 8192, R, C); const int Rb = Epi::PERM ? ((R & ~31) + perm32(R & 31)) : R;
        voffA[i] = (unsigned)(R * K + C) * 2u; voffB[i] = (unsigned)(Rb * K + C) * 2u; }
    const size_t kstep = (size_t)(BK * 2);
    const size_t hstep = (size_t)HALF * K * 2;
    const size_t tstep = 2 * hstep;
    const unsigned ldsw = (unsigned)wid * 1024u;
    const int aoff = lds_byte(wr * 64 + fr, fq * 8), boff = lds_byte(wc * 32 + fr, fq * 8);
#define PG8_SA(b, h) (((b) * 2 + (h)) * HTB)
#define PG8_SB(b, h) ((4 + (b) * 2 + (h)) * HTB)
#define PG8_STAGE(bufoff, gbase, voff) do { _Pragma("unroll") for (int _i = 0; _i < 2; ++_i) \
        __builtin_amdgcn_global_load_lds((const unsigned*)((const char*)(gbase) + (voff)[_i]), (PG8_LAS unsigned*)(lds + (bufoff) + ldsw + _i * 8192), 16, 0, 0); } while (0)
#define PG8_LDA(dst, b, h) do { _Pragma("unroll") for (int m = 0; m < 4; ++m) _Pragma("unroll") for (int k = 0; k < 2; ++k) dst[m][k] = *(const PG8_LAS bf16x8*)(lds + PG8_SA(b, h) + aoff + m * 2048 + k * 1024); } while (0)
#define PG8_LDB(dst, b, h) do { _Pragma("unroll") for (int n = 0; n < 2; ++n) _Pragma("unroll") for (int k = 0; k < 2; ++k) dst[n][k] = *(const PG8_LAS bf16x8*)(lds + PG8_SB(b, h) + boff + n * 2048 + k * 1024); } while (0)
#define PG8_MMA(ai, bj, At, Bt) do { __builtin_amdgcn_s_setprio(1); _Pragma("unroll") for (int m = 0; m < 4; ++m) _Pragma("unroll") for (int n = 0; n < 2; ++n) _Pragma("unroll") for (int k = 0; k < 2; ++k) \
        acc[ai][bj][m][n] = __builtin_amdgcn_mfma_f32_16x16x32_bf16(Bt[n][k], At[m][k], acc[ai][bj][m][n], 0, 0, 0); __builtin_amdgcn_s_setprio(0); } while (0)
#define PG8_WAIT_V(n) asm volatile("s_waitcnt vmcnt(" #n ")" ::: "memory")
#define PG8_WAIT_L(n) asm volatile("s_waitcnt lgkmcnt(" #n ")" ::: "memory")
#define PG8_BAR __builtin_amdgcn_s_barrier()
#define PG8_SCHED __builtin_amdgcn_sched_barrier(0)
    Unit cur, nxt; int ui = 0;
    if (!S.next(0, cur)) return;
    f32x4 acc[2][2][4][2];
#pragma unroll
    for (int a = 0; a < 2; ++a)
#pragma unroll
        for (int b = 0; b < 2; ++b)
#pragma unroll
            for (int m = 0; m < 4; ++m)
#pragma unroll
                for (int n = 0; n < 2; ++n) acc[a][b][m][n] = (f32x4){0.f, 0.f, 0.f, 0.f};
    bf16x8 At[4][2], B0[2][2], B1[2][2];
    const char* cA = (const char*)g.A + (size_t)cur.pm * tstep; const char* cB = (const char*)g.Bt + (size_t)cur.pn * tstep;
    S.a_ready(cur);
    if constexpr (SP2) {
        PG8_STAGE(PG8_SB(0, 0), cB, voffB); PG8_STAGE(PG8_SB(0, 1), cB + hstep, voffB); PG8_STAGE(PG8_SA(0, 0), cA, voffA); PG8_STAGE(PG8_SA(0, 1), cA + hstep, voffA);
        if (wr == 1) PG8_BAR;
        PG8_WAIT_V(2); PG8_BAR;
        PG8_STAGE(PG8_SB(1, 0), cB + kstep, voffB); PG8_STAGE(PG8_SA(1, 0), cA + kstep, voffA); PG8_STAGE(PG8_SB(1, 1), cB + hstep + kstep, voffB);
        PG8_WAIT_V(6); PG8_BAR;
    } else {
        PG8_STAGE(PG8_SB(0, 0), cB, voffB); PG8_STAGE(PG8_SA(0, 0), cA, voffA); PG8_STAGE(PG8_SB(0, 1), cB + hstep, voffB); PG8_STAGE(PG8_SA(0, 1), cA + hstep, voffA);
        if (wr == 1) PG8_BAR;
        PG8_WAIT_V(4); PG8_BAR;
        PG8_STAGE(PG8_SB(1, 0), cB + kstep, voffB); PG8_STAGE(PG8_SA(1, 0), cA + kstep, voffA); PG8_STAGE(PG8_SB(1, 1), cB + hstep + kstep, voffB);
        PG8_WAIT_V(6); PG8_BAR;
    }
    for (;;) {
        const bool has_next = S.next(ui + 1, nxt);
        const char* nA = has_next ? (const char*)g.A + (size_t)nxt.pm * tstep : cA; const char* nB = has_next ? (const char*)g.Bt + (size_t)nxt.pn * tstep : cB;
        for (int t = 0; t < nt; t += 2) {
            const bool last = (t == nt - 2);
            const char* a1 = cA + (size_t)(t + 1) * kstep;
            const char* a2 = last ? nA : cA + (size_t)(t + 2) * kstep; const char* b2 = last ? nB : cB + (size_t)(t + 2) * kstep;
            const char* a3 = a2 + kstep; const char* b3 = b2 + kstep;
            if (last && has_next) S.a_ready(nxt);
            if constexpr (SP2) {
            PG8_LDB(B0, 0, 0); PG8_LDB(B1, 0, 1); PG8_SCHED; PG8_LDA(At, 0, 0); PG8_STAGE(PG8_SA(1, 1), a1 + hstep, voffA);
            PG8_WAIT_V(8); PG8_WAIT_L(0); PG8_BAR; PG8_MMA(0, 0, At, B0); PG8_MMA(0, 1, At, B1); PG8_BAR; PG8_SCHED;
            PG8_LDA(At, 0, 1); PG8_STAGE(PG8_SB(0, 0), b2, voffB); PG8_STAGE(PG8_SB(0, 1), b2 + hstep, voffB); PG8_STAGE(PG8_SA(0, 0), a2, voffA);
            PG8_WAIT_V(8); PG8_WAIT_L(0); PG8_BAR; PG8_MMA(1, 0, At, B0); PG8_MMA(1, 1, At, B1); PG8_BAR; PG8_SCHED;
            PG8_LDB(B0, 1, 0); PG8_LDB(B1, 1, 1); PG8_SCHED; PG8_LDA(At, 1, 0); PG8_STAGE(PG8_SA(0, 1), a2 + hstep, voffA);
            PG8_WAIT_V(8); PG8_WAIT_L(0); PG8_BAR; PG8_MMA(0, 0, At, B0); PG8_MMA(0, 1, At, B1); PG8_BAR; PG8_SCHED;
            PG8_LDA(At, 1, 1); PG8_STAGE(PG8_SB(1, 0), b3, voffB); PG8_STAGE(PG8_SB(1, 1), b3 + hstep, voffB); PG8_STAGE(PG8_SA(1, 0), a3, voffA);
            PG8_WAIT_V(8); PG8_WAIT_L(0); PG8_BAR; PG8_MMA(1, 0, At, B0); PG8_MMA(1, 1, At, B1); PG8_BAR; PG8_SCHED;
            } else {
            PG8_LDB(B0, 0, 0); PG8_SCHED; PG8_LDA(At, 0, 0); PG8_STAGE(PG8_SA(1, 1), a1 + hstep, voffA);
            PG8_WAIT_L(8); PG8_BAR; PG8_WAIT_L(0); PG8_MMA(0, 0, At, B0); PG8_BAR; PG8_SCHED;
            PG8_LDB(B1, 0, 1); PG8_STAGE(PG8_SB(0, 0), b2, voffB);
            PG8_BAR; PG8_WAIT_L(0); PG8_MMA(0, 1, At, B1); PG8_BAR;
            PG8_LDA(At, 0, 1); PG8_STAGE(PG8_SA(0, 0), a2, voffA);
            PG8_BAR; PG8_WAIT_L(0); PG8_MMA(1, 0, At, B0); PG8_BAR; PG8_SCHED;
            PG8_STAGE(PG8_SB(0, 1), b2 + hstep, voffB);
            PG8_WAIT_V(6); PG8_BAR; PG8_MMA(1, 1, At, B1); PG8_BAR;
            PG8_LDB(B0, 1, 0); PG8_SCHED; PG8_LDA(At, 1, 0); PG8_STAGE(PG8_SA(0, 1), a2 + hstep, voffA);
            PG8_WAIT_L(8); PG8_BAR; PG8_WAIT_L(0); PG8_MMA(0, 0, At, B0); PG8_BAR; PG8_SCHED;
            PG8_LDB(B1, 1, 1); PG8_STAGE(PG8_SB(1, 0), b3, voffB);
            PG8_BAR; PG8_WAIT_L(0); PG8_MMA(0, 1, At, B1); PG8_BAR;
            PG8_LDA(At, 1, 1); PG8_STAGE(PG8_SA(1, 0), a3, voffA);
            PG8_BAR; PG8_WAIT_L(0); PG8_MMA(1, 0, At, B0); PG8_BAR; PG8_SCHED;
            PG8_STAGE(PG8_SB(1, 1), b3 + hstep, voffB);
            PG8_WAIT_V(6); PG8_BAR; PG8_MMA(1, 1, At, B1); PG8_BAR;
            }
        }
        if constexpr (ALIGN_EPI) { if (wr == 0) PG8_BAR; }
        if constexpr (!Epi::AFTER_DRAIN) { E(acc, cur, wr, wc, fr, fq); S.done(cur); }
        if (!has_next) break;
#pragma unroll
        for (int a = 0; a < 2; ++a)
#pragma unroll
            for (int b = 0; b < 2; ++b)
#pragma unroll
                for (int m = 0; m < 4; ++m)
#pragma unroll
                    for (int n = 0; n < 2; ++n) acc[a][b][m][n] = (f32x4){0.f, 0.f, 0.f, 0.f};
        cur = nxt; cA = nA; cB = nB; ++ui;
        if constexpr (ALIGN_EPI) { if (wr == 1) PG8_BAR; }
    }
    PG8_WAIT_V(0);
    if constexpr (!ALIGN_EPI) { if (wr == 0) PG8_BAR; }
    PG8_BAR;
    if constexpr (Epi::AFTER_DRAIN) { E.fused(acc, cur, wr, wc, fr, fq, lds, wid, lane); S.done(cur); }
#undef PG8_SA
#undef PG8_SB
#undef PG8_STAGE
#undef PG8_LDA
#undef PG8_LDB
#undef PG8_MMA
#undef PG8_WAIT_V
#undef PG8_WAIT_L
#undef PG8_BAR
#undef PG8_SCHED
}
}
namespace attn {
constexpr int D = 128, LDR = 1024;
constexpr float SCALE = 0.6931471805599453f;
constexpr float THR = 8.f;
constexpr bool WSKIP = false;
constexpr int NW = 8, QBLK = 32, KVBLK = 64, QB = NW * QBLK;
constexpr int SHM_V = KVBLK * D * 2, SHM_K = KVBLK * D * 2;
constexpr int LDS_BYTES = 2 * SHM_V + 2 * SHM_K + NW * 64 * 4;
using bf16 = __hip_bfloat16;
typedef short bf16x8 __attribute__((ext_vector_type(8)));
typedef short s16x4 __attribute__((ext_vector_type(4)));
typedef float f32x16 __attribute__((ext_vector_type(16)));
typedef float f32x4 __attribute__((ext_vector_type(4)));
typedef unsigned u32x4 __attribute__((ext_vector_type(4)));
template <class A, class Bt> struct same_t { static constexpr bool v = false; };
template <class A> struct same_t<A, A> { static constexpr bool v = true; };

#define KSWZ(row, colB) ((row) * 256 + ((colB) ^ (((row) & 7) << 4)))
#define SBAR() __builtin_amdgcn_sched_barrier(0)
__device__ __forceinline__ int v_st(int k, int c) { const int kk = (k & ~0xC) | ((k & 4) << 1) | ((k & 8) >> 1); return ((kk >> 3) * 4 + (c >> 5)) * 512 + ((kk & 7) * 32 + (c & 31)) * 2; }
__device__ __forceinline__ int v_rd_base(int lane) { return ((lane & 3) << 3) | (((lane >> 2) & 3) << 6) | (((lane >> 4) & 1) << 5) | (((lane >> 5) & 1) << 8); }
constexpr int v_rd_off(int d0, int ks, int half) { return d0 * 512 + ks * 4096 + half * 2048; }
__device__ __forceinline__ int crow(int r, int hi) { return (r & 3) + 8 * (r >> 2) + 4 * hi; }
__device__ __forceinline__ unsigned cvtpk(float lo, float hi) {
    unsigned r; asm volatile("v_cvt_pk_bf16_f32 %0, %1, %2" : "=v"(r) : "v"(lo), "v"(hi)); return r;
}
__device__ __forceinline__ bf16x8 pack8(f32x4 a, f32x4 b) {
    u32x4 w = {cvtpk(a[0], a[1]), cvtpk(a[2], a[3]), cvtpk(b[0], b[1]), cvtpk(b[2], b[3])};
    return *reinterpret_cast<bf16x8*>(&w);
}
template <class T> __device__ __forceinline__ bf16x8 load8(const T* p) {
    if constexpr (same_t<T, float>::v) { return pack8(*(const f32x4*)p, *(const f32x4*)(p + 4)); }
    else { return *reinterpret_cast<const bf16x8*>(p); }
}
__device__ __forceinline__ void mask_tile(f32x16& p0, f32x16& p1, int dq, unsigned W) {
    const float NEG = -__builtin_inff();
#pragma unroll
    for (int r = 0; r < 16; ++r) {
        const int c = (r & 3) + 8 * (r >> 2);
        if ((unsigned)(dq - c) >= W) p0[r] = NEG;
        if ((unsigned)(dq - c - 32) >= W) p1[r] = NEG;
    }
}
__device__ __forceinline__ void partialSM(f32x16& p0, f32x16& p1, float& m_reg, float& mn, float& alpha) {
    float pmax = p0[0]; for (int r = 1; r < 16; ++r) pmax = fmaxf(pmax, p0[r]); for (int r = 0; r < 16; ++r) pmax = fmaxf(pmax, p1[r]);
    { auto rr = __builtin_amdgcn_permlane32_swap(__float_as_uint(pmax), __float_as_uint(pmax), false, false);
      pmax = fmaxf(__uint_as_float(rr[0]), __uint_as_float(rr[1])); }
    constexpr float C2 = 1.4426950408889634f * SCALE;
    if (__builtin_expect(__all((pmax - m_reg) * SCALE <= THR), 1)) { mn = m_reg; alpha = 1.f; }
    else { mn = fmaxf(m_reg, pmax); alpha = __builtin_amdgcn_exp2f((m_reg - mn) * C2); m_reg = mn; }
    const float mnL = -mn * C2;
    for (int r = 0; r < 16; ++r) p0[r] = fmaf(p0[r], C2, mnL); for (int r = 0; r < 16; ++r) p1[r] = fmaf(p1[r], C2, mnL);
    for (int r = 0; r < 16; ++r) p0[r] = __builtin_amdgcn_exp2f(p0[r]);
}
__device__ __forceinline__ void finishSM(f32x16& p0, f32x16& p1, float alpha, float& l_reg, bf16x8& pa0, bf16x8& pa1, bf16x8& pa2, bf16x8& pa3) {
    for (int r = 0; r < 16; ++r) p1[r] = __builtin_amdgcn_exp2f(p1[r]);
    float ps = 0; for (int r = 0; r < 16; ++r) ps += p0[r]; for (int r = 0; r < 16; ++r) ps += p1[r];
    { auto rr = __builtin_amdgcn_permlane32_swap(__float_as_uint(ps), __float_as_uint(ps), false, false);
      ps = __uint_as_float(rr[0]) + __uint_as_float(rr[1]); }
    l_reg = l_reg * alpha + ps;
#define PK4(P, B_, OUT) do { unsigned a0 = cvtpk(P[B_+0], P[B_+1]), a1 = cvtpk(P[B_+2], P[B_+3]);                          \
        unsigned b0 = cvtpk(P[B_+4], P[B_+5]), b1 = cvtpk(P[B_+6], P[B_+7]);                                             \
        auto r0 = __builtin_amdgcn_permlane32_swap(a0, b0, false, false); auto r1 = __builtin_amdgcn_permlane32_swap(a1, b1, false, false); \
        u32x4 w = {r0[0], r1[0], r0[1], r1[1]}; OUT = *reinterpret_cast<bf16x8*>(&w); } while (0)
    PK4(p0, 0, pa0); PK4(p0, 8, pa1); PK4(p1, 0, pa2); PK4(p1, 8, pa3);
#undef PK4
}
template <int KB, bool SK>
__device__ __forceinline__ void qkt(f32x16& p0, f32x16& p1, const char* K_lds, int r32, int hi, const bf16x8* qr, bool act) {
    if (SK && !act) { const float NEG = -__builtin_inff();
#pragma unroll
        for (int r = 0; r < 16; ++r) { p0[r] = NEG; p1[r] = NEG; } return; }
    p0 = f32x16{}; p1 = f32x16{};
    const char* kb[4];
#pragma unroll
    for (int dd = 0; dd < 4; ++dd) kb[dd] = K_lds + KB * SHM_K + KSWZ(r32, (dd * 16 + hi * 8) * 2);
#pragma unroll
    for (int d0 = 0; d0 < 8; ++d0) { const char* a = kb[d0 & 3] + (d0 >> 2) * 128;
        bf16x8 b0 = *reinterpret_cast<const bf16x8*>(a);
        bf16x8 b1 = *reinterpret_cast<const bf16x8*>(a + 32 * 256);
        p0 = __builtin_amdgcn_mfma_f32_32x32x16_bf16(b0, qr[d0], p0, 0, 0, 0);
        p1 = __builtin_amdgcn_mfma_f32_32x32x16_bf16(b1, qr[d0], p1, 0, 0, 0); }
}
template <int VB, bool SK>
__device__ __forceinline__ void pv_tile(f32x16* o, int vb0, bf16x8 pa0, bf16x8 pa1, bf16x8 pa2, bf16x8 pa3, bool act) {
    if (SK && !act) return;
#define TRRD(dst, off) asm volatile("ds_read_b64_tr_b16 %0, %1 offset:%2" : "=&v"(dst) : "v"(vb0), "i"(off) : "memory")
#define PV_D0(d0) do { s16x4 l0, l1, l2, l3, h0, h1, h2, h3; constexpr int b_ = VB * SHM_V + v_rd_off(d0, 0, 0);     \
        TRRD(l0, b_); TRRD(h0, b_ + 2048); TRRD(l1, b_ + 4096); TRRD(h1, b_ + 6144); TRRD(l2, b_ + 8192); TRRD(h2, b_ + 10240); TRRD(l3, b_ + 12288); TRRD(h3, b_ + 14336); \
        asm volatile("s_waitcnt lgkmcnt(0)" ::: "memory"); SBAR();                 \
        o[d0] = __builtin_amdgcn_mfma_f32_32x32x16_bf16(pa0, (bf16x8){l0[0], l0[1], l0[2], l0[3], h0[0], h0[1], h0[2], h0[3]}, o[d0], 0, 0, 0);   \
        o[d0] = __builtin_amdgcn_mfma_f32_32x32x16_bf16(pa1, (bf16x8){l1[0], l1[1], l1[2], l1[3], h1[0], h1[1], h1[2], h1[3]}, o[d0], 0, 0, 0);   \
        o[d0] = __builtin_amdgcn_mfma_f32_32x32x16_bf16(pa2, (bf16x8){l2[0], l2[1], l2[2], l2[3], h2[0], h2[1], h2[2], h2[3]}, o[d0], 0, 0, 0);   \
        o[d0] = __builtin_amdgcn_mfma_f32_32x32x16_bf16(pa3, (bf16x8){l3[0], l3[1], l3[2], l3[3], h3[0], h3[1], h3[2], h3[3]}, o[d0], 0, 0, 0); } while (0)
    PV_D0(0); PV_D0(1); PV_D0(2); PV_D0(3);
#undef PV_D0
#undef TRRD
}

template <class TIn, class TOut> struct BlockRef { const TIn* Q; const TIn* K; const TIn* V; TOut* O; int P0; };
template <class TIn> struct Seam {
    bf16x8 qr[8];
    bf16x8 st_v0, st_v1, st_k0, st_k1; f32x4 sf0, sf1, sf2, sf3;
    f32x4 tq[16];
};
__device__ __forceinline__ int swa_jlo(int P0, int W) { const int lowk = P0 - W + 1; return lowk > 0 ? lowk / KVBLK : 0; }
#define ROW(p, k0, rr) ((p) + (size_t)((k0) + (rr)) * LDR + sc)
#define VMW() asm volatile("s_waitcnt vmcnt(0)" ::: "memory")
#define VMWN(n) asm volatile("s_waitcnt vmcnt(%0)" :: "i"(n) : "memory")
#define SLOAD_H(Kp, Vp, k0) do { S.st_v0 = load8<TIn>(ROW(Vp, k0, sr)); S.st_v1 = load8<TIn>(ROW(Vp, k0, 32 + sr));              \
                         S.st_k0 = load8<TIn>(ROW(Kp, k0, sr)); S.st_k1 = load8<TIn>(ROW(Kp, k0, 32 + sr)); } while (0)
#define SWRITE_HK(bf) do { *(bf16x8*)(K_lds + (bf) * SHM_K + kws) = S.st_k0; *(bf16x8*)(K_lds + (bf) * SHM_K + kws + 32 * 256) = S.st_k1; } while (0)
#define SWRITE_HV(bf) do { *(bf16x8*)(V_lds + (bf) * SHM_V + vst0) = S.st_v0; *(bf16x8*)(V_lds + (bf) * SHM_V + vst1) = S.st_v1; } while (0)
#define SWRITE_H(bf) do { SWRITE_HV(bf); SWRITE_HK(bf); } while (0)
#define SLOAD_F(p, k0) do { S.sf0 = *(const f32x4*)ROW(p, k0, sr); S.sf1 = *(const f32x4*)(ROW(p, k0, sr) + 4);                \
                            S.sf2 = *(const f32x4*)ROW(p, k0, 32 + sr); S.sf3 = *(const f32x4*)(ROW(p, k0, 32 + sr) + 4); } while (0)
#define SWRITE_KF(bf) do { *(bf16x8*)(K_lds + (bf) * SHM_K + kws) = pack8(S.sf0, S.sf1); *(bf16x8*)(K_lds + (bf) * SHM_K + kws + 32 * 256) = pack8(S.sf2, S.sf3); } while (0)
#define SWRITE_VF(bf) do { *(bf16x8*)(V_lds + (bf) * SHM_V + vst0) = pack8(S.sf0, S.sf1); *(bf16x8*)(V_lds + (bf) * SHM_V + vst1) = pack8(S.sf2, S.sf3); } while (0)
template <class TIn, class TOut>
__device__ __forceinline__ void causal_swa_prime(const BlockRef<TIn, TOut>& cur, int W, char* lds, Seam<TIn>& S, const int tid_in) {
    constexpr bool F32 = same_t<TIn, float>::v;
    const int tid = tid_in, wid = __builtin_amdgcn_readfirstlane(tid >> 6), lane = tid & 63, r32 = lane & 31, hi = lane >> 5;
    const int sr = tid >> 4, sc = (tid & 15) * 8, kws = KSWZ(sr, sc * 2); char* K_lds = lds + 2 * SHM_V;
    const int kb0 = swa_jlo(cur.P0, W) * KVBLK;
    for (int d0 = 0; d0 < 8; ++d0) S.qr[d0] = load8<TIn>(cur.Q + (size_t)(wid * QBLK + r32) * LDR + d0 * 16 + hi * 8);
    if constexpr (F32) { SLOAD_F((const float*)cur.K, kb0); VMW(); SWRITE_KF(0); SBAR(); SLOAD_F((const float*)cur.V, kb0); }
    else { SLOAD_H(cur.K, cur.V, kb0); VMW(); SWRITE_HK(0); }
    __syncthreads();
}
template <class TIn, class TOut>
__device__ __forceinline__ void causal_swa_block(const BlockRef<TIn, TOut>& cur, const BlockRef<TIn, TOut>& nxt, int skv, int W, char* lds, Seam<TIn>& S, const int tid_in) {
    constexpr bool F32 = same_t<TIn, float>::v;
    const int tid = tid_in, wid = __builtin_amdgcn_readfirstlane(tid >> 6), lane = tid & 63, r32 = lane & 31, hi = lane >> 5;
    const int j_lo = swa_jlo(cur.P0, W);
    int j_hi = (cur.P0 + QB - 1) / KVBLK + 1; if (j_hi > skv / KVBLK) j_hi = skv / KVBLK;
    const int NT = j_hi - j_lo;
    const int kbn = swa_jlo(nxt.P0, W) * KVBLK;
    const int qlo = cur.P0 + wid * QBLK, qm = qlo + r32 - 4 * hi;
    char* V_lds = lds; char* K_lds = lds + 2 * SHM_V;
    float* ws = (float*)(lds + 2 * SHM_V + 2 * SHM_K) + wid * 64; float* li_l = ws, * al_l = ws + 32;
    float m_reg = -1e30f, l_reg = 0; f32x16 o[4] = {};
    const int sr = tid >> 4, sc = (tid & 15) * 8, vst0 = v_st(sr, sc), vst1 = v_st(32 + sr, sc), kws = KSWZ(sr, sc * 2);
    const int vb0 = (int)(uintptr_t)V_lds + v_rd_base(lane);
    const TIn* Kh = cur.K; const TIn* Vh = cur.V;
#define RESC(a) do { if (__any((a) < 1.f)) { if (hi == 0) al_l[r32] = (a); asm volatile("s_waitcnt lgkmcnt(0)" ::: "memory");              \
                     for (int d_ = 0; d_ < 4; ++d_) for (int r = 0; r < 16; ++r) o[d_][r] *= al_l[crow(r, hi)]; } } while (0)
#define KBASE(t) ((j_lo + (t)) * KVBLK)
#define ACT(t) (KBASE(t) <= qlo + QBLK - 1 && KBASE(t) + KVBLK - 1 >= qlo - W + 1)
#define MASKT(P0_, P1_, t) do { const int kb_ = KBASE(t); if ((!SK || ACT(t)) && (kb_ + KVBLK - 1 > qlo || kb_ <= qlo + QBLK - 1 - W)) mask_tile(P0_, P1_, qm - kb_, (unsigned)W); } while (0)
    constexpr int NQL = F32 ? 16 : 8;
    constexpr bool SK = WSKIP && !F32;
#define SEAM_K0() do { VMWN(NQL); if constexpr (F32) { SWRITE_KF(0); SBAR(); SLOAD_F((const float*)nxt.V, kbn); } else { SWRITE_HK(0); } SBAR(); } while (0)
    f32x16 pA0, pA1, pB0, pB1; float mnA, mnB, alA, alB; bf16x8 pa0, pa1, pa2, pa3;
    if constexpr (F32) { VMW(); SWRITE_VF(0); SBAR(); } else { SWRITE_HV(0); SBAR(); }
    if (NT > 1) { if constexpr (F32) SLOAD_F((const float*)Kh, KBASE(1)); else SLOAD_H(Kh, Vh, KBASE(1)); }
    SBAR(); qkt<0, SK>(pA0, pA1, K_lds, r32, hi, S.qr, ACT(0));
    if constexpr (F32) { if (NT > 1) { VMW(); SWRITE_KF(1); SBAR(); SLOAD_F((const float*)Vh, KBASE(1)); } }
    MASKT(pA0, pA1, 0); partialSM(pA0, pA1, m_reg, mnA, alA);
    if (NT > 1) { VMW(); if constexpr (F32) { SWRITE_VF(1); SBAR(); if (NT > 2) SLOAD_F((const float*)Kh, KBASE(2)); } else SWRITE_H(1); }
    __syncthreads();
#define HALF_STEP(PX0, PX1, mnX, alX, PY0, PY1, alY, t, KB, VB, SB) do {                                                      \
        SBAR(); qkt<KB, SK>(PX0, PX1, K_lds, r32, hi, S.qr, ACT(t));                                             \
        finishSM(PY0, PY1, alY, l_reg, pa0, pa1, pa2, pa3); SBAR();                                                           \
        if ((t) + 1 < NT) { if constexpr (F32) { VMW(); SWRITE_KF(SB); SBAR(); SLOAD_F((const float*)Vh, KBASE((t) + 1)); }  \
                            else { SLOAD_H(Kh, Vh, KBASE((t) + 1)); } SBAR(); }                                               \
        pv_tile<VB, SK>(o, vb0, pa0, pa1, pa2, pa3, ACT((t) - 1)); MASKT(PX0, PX1, (t)); partialSM(PX0, PX1, m_reg, mnX, alX);                                        \
        __syncthreads();                                                                                                      \
        if ((t) + 1 < NT) { VMW(); if constexpr (F32) { SWRITE_VF(SB); SBAR(); if ((t) + 2 < NT) SLOAD_F((const float*)Kh, KBASE((t) + 2)); } \
                            else { SWRITE_H(SB); } }                                                                          \
        RESC(alX); __syncthreads(); } while (0)
    for (int t = 1; t + 1 < NT; t += 2) {
        HALF_STEP(pB0, pB1, mnB, alB, pA0, pA1, alA, t, 1, 0, 0);
        HALF_STEP(pA0, pA1, mnA, alA, pB0, pB1, alB, t + 1, 0, 1, 1);
    }
    const bool even = (NT & 1) == 0;
    if (even) { SBAR(); qkt<1, SK>(pB0, pB1, K_lds, r32, hi, S.qr, ACT(NT - 1)); SBAR(); }
#define QROW(e) (nxt.Q + (size_t)(wid * QBLK + r32) * LDR + ((e) >> 1) * 16 + hi * 8 + ((e) & 1) * 4)
    if constexpr (F32) { SLOAD_F((const float*)nxt.K, kbn); SBAR();
#pragma unroll
        for (int e = 0; e < 8; ++e) S.tq[e] = *(const f32x4*)QROW(e); }
    else { SLOAD_H(nxt.K, nxt.V, kbn); SBAR();
#pragma unroll
        for (int d0 = 0; d0 < 8; ++d0) S.qr[d0] = load8<TIn>(nxt.Q + (size_t)(wid * QBLK + r32) * LDR + d0 * 16 + hi * 8); }
    SBAR();
    finishSM(pA0, pA1, alA, l_reg, pa0, pa1, pa2, pa3); SBAR();
    if constexpr (F32) {
#pragma unroll
        for (int e = 8; e < 16; ++e) S.tq[e] = *(const f32x4*)QROW(e); SBAR(); }
#undef QROW
    pv_tile<0, SK>(o, vb0, pa0, pa1, pa2, pa3, ACT(even ? NT - 2 : NT - 1));
    if (even) { MASKT(pB0, pB1, NT - 1); partialSM(pB0, pB1, m_reg, mnB, alB); __syncthreads(); RESC(alB);
        finishSM(pB0, pB1, alB, l_reg, pa0, pa1, pa2, pa3); SBAR(); pv_tile<1, SK>(o, vb0, pa0, pa1, pa2, pa3, ACT(NT - 1)); }
    SBAR(); SEAM_K0();
    if (hi == 0) li_l[r32] = l_reg; asm volatile("s_waitcnt lgkmcnt(0)" ::: "memory");
    float rli[16];
#pragma unroll
    for (int r = 0; r < 16; ++r) rli[r] = __builtin_amdgcn_rcpf(li_l[crow(r, hi)]);
    TOut* Ow = cur.O + (size_t)(wid * QBLK) * LDR;
    if constexpr (same_t<TOut, float>::v) {
#pragma unroll
        for (int r = 0; r < 16; ++r) { const int orow = crow(r, hi);
#pragma unroll
            for (int d0 = 0; d0 < 4; ++d0) Ow[(size_t)orow * LDR + d0 * 32 + r32] = o[d0][r] * rli[r]; }
    } else {
        unsigned short* stg = (unsigned short*)(lds + LDS_BYTES) + wid * 4096;
        int hi_e = hi, r32_e = r32, lane_e = lane; asm volatile("" : "+v"(hi_e), "+v"(r32_e), "+v"(lane_e));
#pragma unroll
        for (int r = 0; r < 16; ++r) { const int orow = crow(r, hi_e);
#pragma unroll
            for (int d0 = 0; d0 < 4; ++d0) stg[orow * 128 + d0 * 32 + r32_e] = (unsigned short)cvtpk(o[d0][r] * rli[r], 0.f); }
        asm volatile("s_waitcnt lgkmcnt(0)" ::: "memory");
#pragma unroll
        for (int i = 0; i < 8; ++i) { const int row = i * 4 + (lane_e >> 4), ch = lane_e & 15; const u32x4 v = *(const u32x4*)(stg + row * 128 + ch * 8); *(u32x4*)(Ow + (unsigned)(row * LDR + ch * 8)) = v; }
    }
    if constexpr (F32) {
#pragma unroll
        for (int d0 = 0; d0 < 8; ++d0) S.qr[d0] = pack8(S.tq[2 * d0], S.tq[2 * d0 + 1]); }
    __syncthreads();
#undef RESC
#undef KBASE
#undef ACT
#undef MASKT
#undef SEAM_K0
#undef HALF_STEP
}
#undef ROW
#undef VMW
#undef VMWN
#undef SLOAD_H
#undef SWRITE_HK
#undef SWRITE_HV
#undef SWRITE_H
#undef SLOAD_F
#undef SWRITE_KF
#undef SWRITE_VF

}
namespace pg8 {
template <class F> struct EpiAdapt {
    static constexpr bool PERM = true, AFTER_DRAIN = false; F f;
    __device__ __forceinline__ void operator()(const f32x4 (&acc)[2][2][4][2], const Unit& u, int wr, int wc, int fr, int fq) const {
        const int c = wc * 32 + fq * 8;
        const typename F::Col cc = f.col(u.pn, c, u.pm);
#pragma unroll
        for (int ai = 0; ai < 2; ++ai) {
            typename F::Ld ld[4];
#pragma unroll
            for (int m = 0; m < 4; ++m) ld[m] = f.load(u.pm * BM + ai * HALF + wr * 64 + m * 16 + fr, u.pn, c);
#pragma unroll
            for (int m = 0; m < 4; ++m) {
                const int row = u.pm * BM + ai * HALF + wr * 64 + m * 16 + fr;
                float lo[8], hi[8];
#pragma unroll
                for (int j = 0; j < 4; ++j) { lo[j] = acc[ai][0][m][0][j]; lo[4 + j] = acc[ai][0][m][1][j]; hi[j] = acc[ai][1][m][0][j]; hi[4 + j] = acc[ai][1][m][1][j]; }
                f.apply(row, u.pn, c, cc, ld[m], lo, hi);
            }
        }
    }
};
}

typedef unsigned short bf16_t;
typedef short bf16x8 __attribute__((ext_vector_type(8)));
typedef float f32x4 __attribute__((ext_vector_type(4)));
typedef unsigned u32x4 __attribute__((ext_vector_type(4)));
#define LAS __attribute__((address_space(3)))

constexpr int D = 2048, NB = 4, S = 4096, M = NB * S, NIN = 7168, DFF = 5632, NGU = 2 * DFF;
constexpr float LN_EPS = 1e-5f, RMS_EPS = 1e-6f;
constexpr float ALPHA = 1.189207115002721f;
constexpr float LAMBDA_INIT = 0.2f;
constexpr float LOG2E = 1.4426950408889634f;
constexpr float QSCALE = 0.08838834764831845f;
constexpr int NWAVES = 8, NTHREADS = 512;
#ifndef PROBE_MASK
#define PROBE_MASK 0
#endif
#define REPS(k) for (int rep_ = 0; rep_ < (((PROBE_MASK) >> (k)) & 1 ? 2 : 1); ++rep_)
constexpr int LDS_BYTES = 147456;

constexpr size_t MiB = 1u << 20;
constexpr size_t OFF_BAR = 0;
constexpr size_t OFF_MOD = 64 * 1024, OFF_LB = 320 * 1024, OFF_LAM = 328 * 1024;
constexpr size_t OFF_COS = 1 * MiB, OFF_SIN = 5 * MiB;
constexpr size_t OFF_WIN = 16 * MiB, OFF_WO = 44 * MiB, OFF_WGU = 52 * MiB, OFF_WD = 96 * MiB;
constexpr size_t OFF_U = 120 * MiB, OFF_MIX = 184 * MiB;
constexpr size_t OFF_QH = 248 * MiB, OFF_VH = 280 * MiB, OFF_GH = 312 * MiB, OFF_LOGF = 344 * MiB, OFF_QA = 408 * MiB, OFF_KA = 440 * MiB, OFF_VA = 472 * MiB;
constexpr size_t OFF_T1 = 248 * MiB, OFF_H1 = 376 * MiB, OFF_HFF = 184 * MiB;
constexpr size_t OFF_O1 = 120 * MiB, OFF_O2 = 152 * MiB;
constexpr size_t WS_NEED = 504 * MiB;

__device__ __forceinline__ float bf2f(bf16_t v) { return __uint_as_float((unsigned)v << 16); }
__device__ __forceinline__ bf16_t f2bf(float f) { unsigned u = __float_as_uint(f); return (bf16_t)((u + 0x7fffu + ((u >> 16) & 1u)) >> 16); }
__device__ __forceinline__ unsigned pk2(float lo, float hi) { return (unsigned)f2bf(lo) | ((unsigned)f2bf(hi) << 16); }
typedef float f32x2_t __attribute__((ext_vector_type(2))); typedef __bf16 bf16x2_t __attribute__((ext_vector_type(2)));
__device__ __forceinline__ unsigned cvtpk_s(float lo, float hi) { f32x2_t v = {lo, hi}; bf16x2_t b = __builtin_convertvector(v, bf16x2_t); return __builtin_bit_cast(unsigned, b); }
__device__ __forceinline__ float ex2(float x) { return __builtin_amdgcn_exp2f(x); }
__device__ __forceinline__ float sigmoidf_(float x) { return 1.f / (1.f + __expf(-x)); }
__device__ __forceinline__ float wave_sum(float v) {
#pragma unroll
    for (int o = 1; o < 64; o <<= 1) v += __shfl_xor(v, o);
    return v;
}

struct Ptrs {
    const float *x, *c; const int* positions; const float *w_ada, *b_ada, *w_in, *lb_logits, *hg_norm_w, *lq1, *lk1, *lq2, *lk2, *subln_w, *w_out, *ln1_g, *ln1_b, *w_gate, *w_up, *w_down, *ln2_g, *ln2_b;
    float* out; float *mod, *lbv, *lam, *cosT, *sinT; bf16_t *WinT, *WoT, *WguT, *WdT, *U, *MIX, *Qh, *Vh, *Gh, *Qa, *Ka, *Va, *Hff, *O1, *O2; float *Logf, *T1, *H1;
};

struct Epi1 {
    bf16_t *Qh, *Vh, *Gh, *Qa, *Ka, *Va; float* Logf; const float* lbv; const int* positions;
    struct Col { f32x4 a0, a1, b0, b1; };
    struct Ld { int pos; };
    __device__ __forceinline__ Col col(int pn, int c, int) const {
        const int seg = pn >> 2, pt = pn & 3; Col r; r.a0 = r.a1 = r.b0 = r.b1 = (f32x4){0.f, 0.f, 0.f, 0.f};
        if (seg == 1) { const float* p = lbv + 256 * pt + c; r.a0 = *(const f32x4*)p; r.a1 = *(const f32x4*)(p + 4); r.b0 = *(const f32x4*)(p + 128); r.b1 = *(const f32x4*)(p + 132); }
        if (seg == 4 || seg == 5) { const int d0 = c & 63;
#pragma unroll
            for (int j = 0; j < 4; ++j) { r.a0[j] = __builtin_amdgcn_exp2f(-(float)(d0 + j) * 0.20762050593046014f) * 0.15915494309189535f; r.a1[j] = __builtin_amdgcn_exp2f(-(float)(d0 + 4 + j) * 0.20762050593046014f) * 0.15915494309189535f; } }
        return r;
    }
    __device__ __forceinline__ Ld load(int row, int pn, int) const { Ld l; l.pos = 0; const int seg = pn >> 2; if (seg == 4 || seg == 5) l.pos = positions[row]; return l; }
    __device__ __forceinline__ void apply(int row, int pn, int c, const Col& cc, const Ld& ld, const float (&lo)[8], const float (&hi)[8]) const {
        const int seg = pn >> 2, pt = pn & 3;
        if (seg == 4 || seg == 5) {
            const int head = 2 * pt + (c >> 6), d0 = c & 63; const float sc = (seg == 4) ? QSCALE * LOG2E : 1.f; const float pf = (float)ld.pos;
            float o1[8], o2[8];
#pragma unroll
            for (int j = 0; j < 8; ++j) { const float rev = pf * (j < 4 ? cc.a0[j & 3] : cc.a1[j & 3]); const float fr_ = rev - __builtin_floorf(rev);
                const float cs = __builtin_amdgcn_cosf(fr_), sn = __builtin_amdgcn_sinf(fr_);
                o1[j] = (lo[j] * cs - hi[j] * sn) * sc; o2[j] = (hi[j] * cs + lo[j] * sn) * sc; }
            bf16_t* dst = (seg == 4 ? Qa : Ka) + (size_t)row * 1024 + head * 128 + d0;
            u32x4 w1 = {cvtpk_s(o1[0], o1[1]), cvtpk_s(o1[2], o1[3]), cvtpk_s(o1[4], o1[5]), cvtpk_s(o1[6], o1[7])}, w2 = {cvtpk_s(o2[0], o2[1]), cvtpk_s(o2[2], o2[3]), cvtpk_s(o2[4], o2[5]), cvtpk_s(o2[6], o2[7])};
            *(u32x4*)dst = w1; *(u32x4*)(dst + 64) = w2;
            return;
        }
#pragma unroll
        for (int h = 0; h < 2; ++h) {
            const int col = 256 * pt + 128 * h + c; float v[8];
#pragma unroll
            for (int j = 0; j < 8; ++j) v[j] = h ? hi[j] : lo[j];
            if (seg == 1) {
                float* dst = Logf + (size_t)row * 1024 + col;
                f32x4 r0, r1;
#pragma unroll
                for (int j = 0; j < 8; ++j) { const float lb = h ? (j < 4 ? cc.b0[j & 3] : cc.b1[j & 3]) : (j < 4 ? cc.a0[j & 3] : cc.a1[j & 3]); const float f = lb + (1.f - lb) * sigmoidf_(v[j]); if (j < 4) r0[j & 3] = __log2f(f); else r1[j & 3] = __log2f(f); }
                *(f32x4*)dst = r0; *(f32x4*)(dst + 4) = r1;
            } else {
                if (seg == 0) {
#pragma unroll
                    for (int j = 0; j < 8; ++j) v[j] = v[j] * sigmoidf_(v[j]) * QSCALE;
                } else if (seg == 3) {
#pragma unroll
                    for (int j = 0; j < 8; ++j) v[j] = sigmoidf_(v[j]);
                }
                bf16_t* dst = (seg == 0 ? Qh : seg == 2 ? Vh : seg == 3 ? Gh : Va) + (size_t)row * 1024 + col;
                u32x4 w = {cvtpk_s(v[0], v[1]), cvtpk_s(v[2], v[3]), cvtpk_s(v[4], v[5]), cvtpk_s(v[6], v[7])};
                *(u32x4*)dst = w;
            }
        }
    }
};
struct EpiRes {
    const float* res; const float* gate; float* out;
    struct Col { f32x4 g[4]; };
    struct Ld { f32x4 r[4]; };
    __device__ __forceinline__ Col col(int pn, int c, int pm) const { Col r; const float* p = gate + (size_t)(pm >> 4) * 6 * D + 256 * pn + c; r.g[0] = *(const f32x4*)p; r.g[1] = *(const f32x4*)(p + 4); r.g[2] = *(const f32x4*)(p + 128); r.g[3] = *(const f32x4*)(p + 132); return r; }
    __device__ __forceinline__ Ld load(int row, int pn, int c) const { Ld l; const float* p = res + (size_t)row * D + 256 * pn + c; l.r[0] = *(const f32x4*)p; l.r[1] = *(const f32x4*)(p + 4); l.r[2] = *(const f32x4*)(p + 128); l.r[3] = *(const f32x4*)(p + 132); return l; }
    __device__ __forceinline__ void apply(int row, int pn, int c, const Col& cc, const Ld& ld, const float (&lo)[8], const float (&hi)[8]) const {
        float* p = out + (size_t)row * D + 256 * pn + c;
        f32x4 v0, v1, v2, v3;
#pragma unroll
        for (int j = 0; j < 4; ++j) { v0[j] = lo[j]; v1[j] = lo[4 + j]; v2[j] = hi[j]; v3[j] = hi[4 + j]; }
        *(f32x4*)p = ld.r[0] * ALPHA + cc.g[0] * v0; *(f32x4*)(p + 4) = ld.r[1] * ALPHA + cc.g[1] * v1; *(f32x4*)(p + 128) = ld.r[2] * ALPHA + cc.g[2] * v2; *(f32x4*)(p + 132) = ld.r[3] * ALPHA + cc.g[3] * v3;
    }
};
struct EpiSwiglu {
    bf16_t* Hff;
    struct Col {}; struct Ld {};
    __device__ __forceinline__ Col col(int, int, int) const { return Col{}; }
    __device__ __forceinline__ Ld load(int, int, int) const { return Ld{}; }
    __device__ __forceinline__ void apply(int row, int pn, int c, const Col&, const Ld&, const float (&lo)[8], const float (&hi)[8]) const {
        float v[8];
#pragma unroll
        for (int j = 0; j < 8; ++j) v[j] = lo[j] * sigmoidf_(lo[j]) * hi[j];
        u32x4 w = {cvtpk_s(v[0], v[1]), cvtpk_s(v[2], v[3]), cvtpk_s(v[4], v[5]), cvtpk_s(v[6], v[7])};
        *(u32x4*)(Hff + (size_t)row * DFF + 128 * pn + c) = w;
    }
};

__device__ __forceinline__ int src_col_win(int n) {
    const int pn = n >> 8, t = n & 255, seg = pn >> 2, pt = pn & 3;
    if (seg == 4 || seg == 5) { const int bj = t >> 7, o = t & 127; return seg * 1024 + (2 * pt + (o >> 6)) * 128 + (o & 63) + 64 * bj; }
    return n;
}
__device__ __forceinline__ void transpose_item(const float* Wsrc, int ldw, bf16_t* WTrow, int K, int k0, LAS float* scr, int lane) {
#pragma unroll 8
    for (int i = 0; i < 32; ++i) { const int kk = 2 * i + (lane >> 5); scr[kk * 33 + (lane & 31)] = Wsrc[(size_t)(k0 + kk) * ldw + (lane & 31)]; }
    asm volatile("s_waitcnt lgkmcnt(0)" ::: "memory");
    const int c = lane & 7;
#pragma unroll
    for (int j = 0; j < 4; ++j) { const int n = (lane >> 3) + 8 * j; const LAS float* s = scr + (8 * c) * 33 + n;
        u32x4 o; o.x = pk2(s[0 * 33], s[1 * 33]); o.y = pk2(s[2 * 33], s[3 * 33]); o.z = pk2(s[4 * 33], s[5 * 33]); o.w = pk2(s[6 * 33], s[7 * 33]);
        *(u32x4*)(WTrow + (size_t)n * K + k0 + 8 * c) = o; }
    asm volatile("s_waitcnt lgkmcnt(0)" ::: "memory");
}
__device__ __forceinline__ void p0_prologue(const Ptrs& P, LAS unsigned char* lds, int tid, int lane, int wave) {
    __syncthreads();
    {
        LAS float* cond = (LAS float*)lds;
        LAS float* part = (LAS float*)(lds + 32768);
        for (int i = tid; i < NB * D; i += NTHREADS) { const float v = P.c[i]; cond[i] = v / (1.f + __expf(-v)); }
        __syncthreads();
        for (int chunk = blockIdx.x; chunk < 6 * D / 48; chunk += gridDim.x) {
            const int col = tid % 48, ks = tid / 48, e = chunk * 48 + col;
            if (tid < 480) {
                float a0 = 0, a1 = 0, a2 = 0, a3 = 0;
#pragma unroll 8
                for (int k = ks; k < D; k += 10) { const float w = P.w_ada[(size_t)k * (6 * D) + e]; a0 += cond[k] * w; a1 += cond[D + k] * w; a2 += cond[2 * D + k] * w; a3 += cond[3 * D + k] * w; }
                LAS float* pp = part + (ks * 48 + col) * 4; pp[0] = a0; pp[1] = a1; pp[2] = a2; pp[3] = a3;
            }
            __syncthreads();
            if (tid < 192) { const int cc = tid % 48, b = tid / 48; float s = P.b_ada[chunk * 48 + cc];
#pragma unroll
                for (int q = 0; q < 10; ++q) s += part[(q * 48 + cc) * 4 + b];
                P.mod[(size_t)b * 6 * D + chunk * 48 + cc] = s; }
            __syncthreads();
        }
    }
    if (blockIdx.x == 0) {
        for (int i = tid; i < 1024; i += NTHREADS) P.lbv[i] = 1.f / (1.f + __expf(P.lb_logits[1024 + i] - P.lb_logits[i]));
        if (tid == 0) { float s1 = 0, s2 = 0; for (int i = 0; i < 128; ++i) { s1 += P.lq1[i] * P.lk1[i]; s2 += P.lq2[i] * P.lk2[i]; } P.lam[0] = expf(s1) - expf(s2) + LAMBDA_INIT; }
    }
    {
        LAS float* scr = (LAS float*)(lds + wave * 16384);
        const int gw = blockIdx.x * NWAVES + wave, NGW = gridDim.x * NWAVES;
        constexpr int I_IN = (D / 64) * (NIN / 32), I_O = (D / 64) * (D / 32), I_GU = (D / 64) * (NGU / 32), I_D = (DFF / 64) * (D / 32);
        for (int it = gw; it < I_IN + I_O + I_GU + I_D; it += NGW) {
            int r = it;
            if (r < I_IN) { const int nb = r % (NIN / 32), kb = r / (NIN / 32), n0 = nb * 32; transpose_item(P.w_in + src_col_win(n0), NIN, P.WinT + (size_t)n0 * D, D, kb * 64, scr, lane); continue; } r -= I_IN;
            if (r < I_O) { const int nb = r % (D / 32), kb = r / (D / 32), n0 = nb * 32; transpose_item(P.w_out + n0, D, P.WoT + (size_t)n0 * D, D, kb * 64, scr, lane); continue; } r -= I_O;
            if (r < I_GU) { const int nb = r % (NGU / 32), kb = r / (NGU / 32), n0 = nb * 32, pn = n0 >> 8, t = n0 & 255;
                const float* src = (t < 128) ? P.w_gate + 128 * pn + t : P.w_up + 128 * pn + (t - 128);
                transpose_item(src, DFF, P.WguT + (size_t)n0 * D, D, kb * 64, scr, lane); continue; } r -= I_GU;
            { const int nb = r % (D / 32), kb = r / (D / 32), n0 = nb * 32; transpose_item(P.w_down + n0, D, P.WdT + (size_t)n0 * DFF, DFF, kb * 64, scr, lane); }
        }
    }
}

__device__ __forceinline__ void ln_stats(const f32x4 (&v)[8], float& mean, float& rstd) {
    float s = 0;
#pragma unroll
    for (int j = 0; j < 8; ++j) s += (v[j][0] + v[j][1]) + (v[j][2] + v[j][3]);
    mean = wave_sum(s) * (1.f / D); float q = 0;
#pragma unroll
    for (int j = 0; j < 8; ++j) { const f32x4 d = v[j] - mean; q += (d[0] * d[0] + d[1] * d[1]) + (d[2] * d[2] + d[3] * d[3]); }
    rstd = rsqrtf(wave_sum(q) * (1.f / D) + LN_EPS);
}
__device__ __forceinline__ void mod_store_bf16(const f32x4 (&v)[8], float mean, float rstd, const float* sc, const float* sh, bf16_t* dst, int lane) {
#pragma unroll
    for (int j = 0; j < 8; ++j) { const int col = 4 * lane + 256 * j; const f32x4 o = (v[j] - mean) * rstd * (*(const f32x4*)(sc + col) + 1.f) + *(const f32x4*)(sh + col);
        uint2 w; w.x = pk2(o[0], o[1]); w.y = pk2(o[2], o[3]); *(uint2*)(dst + col) = w; }
}
__device__ __forceinline__ void p1_ln_mod(const Ptrs& P, int lane, int wave) {
    const int stride = gridDim.x * NWAVES; int row = blockIdx.x * NWAVES + wave;
    f32x4 nx[8];
    if (row < M) { const f32x4* xr = (const f32x4*)(P.x + (size_t)row * D) + lane;
#pragma unroll
        for (int j = 0; j < 8; ++j) nx[j] = xr[64 * j]; }
    for (; row < M; row += stride) {
        f32x4 v[8];
#pragma unroll
        for (int j = 0; j < 8; ++j) v[j] = nx[j];
        if (row + stride < M) { const f32x4* xr = (const f32x4*)(P.x + (size_t)(row + stride) * D) + lane;
#pragma unroll
            for (int j = 0; j < 8; ++j) nx[j] = xr[64 * j]; }
        float mean, rstd; ln_stats(v, mean, rstd);
        const float* mb = P.mod + (size_t)(row / S) * 6 * D;
        mod_store_bf16(v, mean, rstd, mb + D, mb, P.U + (size_t)row * D, lane);
    }
}
__device__ __forceinline__ void p5_ln1(const Ptrs& P, int lane, int wave) {
    const int stride = gridDim.x * NWAVES; int row = blockIdx.x * NWAVES + wave;
    f32x4 nx[8];
    if (row < M) { const f32x4* xr = (const f32x4*)(P.T1 + (size_t)row * D) + lane;
#pragma unroll
        for (int j = 0; j < 8; ++j) nx[j] = xr[64 * j]; }
    for (; row < M; row += stride) {
        f32x4 v[8];
#pragma unroll
        for (int j = 0; j < 8; ++j) v[j] = nx[j];
        if (row + stride < M) { const f32x4* xr = (const f32x4*)(P.T1 + (size_t)(row + stride) * D) + lane;
#pragma unroll
            for (int j = 0; j < 8; ++j) nx[j] = xr[64 * j]; }
        float mean, rstd; ln_stats(v, mean, rstd);
#pragma unroll
        for (int j = 0; j < 8; ++j) { const int col = 4 * lane + 256 * j; v[j] = (v[j] - mean) * rstd * *(const f32x4*)(P.ln1_g + col) + *(const f32x4*)(P.ln1_b + col);
            *(f32x4*)(P.H1 + (size_t)row * D + col) = v[j]; }
        ln_stats(v, mean, rstd);
        const float* mb = P.mod + (size_t)(row / S) * 6 * D;
        mod_store_bf16(v, mean, rstd, mb + 4 * D, mb + 3 * D, P.U + (size_t)row * D, lane);
    }
}
__device__ __forceinline__ void p8_ln_final(const Ptrs& P, int lane, int wave) {
    const int stride = gridDim.x * NWAVES; int row = blockIdx.x * NWAVES + wave;
    f32x4 nx[8];
    if (row < M) { const f32x4* xr = (const f32x4*)(P.out + (size_t)row * D) + lane;
#pragma unroll
        for (int j = 0; j < 8; ++j) nx[j] = xr[64 * j]; }
    for (; row < M; row += stride) {
        f32x4 v[8];
#pragma unroll
        for (int j = 0; j < 8; ++j) v[j] = nx[j];
        if (row + stride < M) { const f32x4* xr = (const f32x4*)(P.out + (size_t)(row + stride) * D) + lane;
#pragma unroll
            for (int j = 0; j < 8; ++j) nx[j] = xr[64 * j]; }
        float mean, rstd; ln_stats(v, mean, rstd);
        f32x4* xw = (f32x4*)(P.out + (size_t)row * D) + lane;
#pragma unroll
        for (int j = 0; j < 8; ++j) { const int col = 4 * lane + 256 * j; xw[64 * j] = (v[j] - mean) * rstd * *(const f32x4*)(P.ln2_g + col) + *(const f32x4*)(P.ln2_b + col); }
    }
}

__device__ __forceinline__ void hgrn_simple_item(const Ptrs& P, int item, unsigned char* lds, int tid) {
    float* sf = (float*)lds; float* sk = sf + 128; float* sq = sk + 128; float* po = sq + 128  ; float* red = po + 512;
    const int b = item >> 3, h = item & 7, v = tid & 127, qd = tid >> 7;
    float St[32];
#pragma unroll
    for (int d = 0; d < 32; ++d) St[d] = 0.f;
    const float w = P.hg_norm_w[v];
    for (int t = 0; t < S; ++t) {
        const size_t off = (size_t)(b * S + t) * 1024 + h * 128 + v;
        if (qd == 0) { const float f = exp2f(P.Logf[off]); sf[v] = f; sk[v] = 1.f - f; sq[v] = bf2f(P.Qh[off]); }
        const float vv = bf2f(P.Vh[off]);
        __syncthreads();
        float o = 0.f;
#pragma unroll
        for (int d = 0; d < 32; ++d) { const int dd = qd * 32 + d; St[d] = sf[dd] * St[d] + sk[dd] * vv; o += St[d] * sq[dd]; }
        po[qd * 128 + v] = o;
        __syncthreads();
        if (qd == 0) { o = (po[v] + po[128 + v]) + (po[256 + v] + po[384 + v]); const float ss = wave_sum(o * o); if ((tid & 63) == 0) red[tid >> 6] = ss; }
        __syncthreads();
        if (qd == 0) { const float tot = red[0] + red[1]; const float gg = bf2f(P.Gh[off]);
            P.MIX[(size_t)(b * S + t) * D + h * 128 + v] = f2bf(o * rsqrtf(tot * (1.f / 128.f) + RMS_EPS) * w * gg); }
    }
    __syncthreads();
}

typedef short s16x4 __attribute__((ext_vector_type(4)));
typedef unsigned u32x2 __attribute__((ext_vector_type(2)));
namespace hg {
constexpr int SETB = 49664, O_QT = 0, O_KT = 8704, O_QD = 17408, O_KDT = 26112, O_VT = 36352, O_XT = 46592, O_DL = 49152, O_TT = 2 * SETB, O_RED = 0;
constexpr size_t OUT_QCUM = 64 * MiB, OUT_SLOC = 96 * MiB, OUT_GTOT = 112 * MiB;
}
#define HG_MFMA(a, b, c) __builtin_amdgcn_mfma_f32_16x16x32_bf16((a), (b), (c), 0, 0, 0)
__device__ __forceinline__ void hgrn_local_item(const Ptrs& P, int item, LAS unsigned char* lds, int tid, int lane, int wave) {
    using namespace hg;
    const int b = item >> 6, h = (item >> 3) & 7, seg = item & 7;
    const int d = tid & 127, tg = tid >> 7, fr = lane & 15, fq = lane >> 4;
    const size_t row00 = (size_t)b * S + (size_t)seg * 512;
    const int colh = h * 128;
    float* Oloc = P.out; bf16_t* Qcum = (bf16_t*)((unsigned char*)P.out + OUT_QCUM); float* Sloc = (float*)((unsigned char*)P.out + OUT_SLOC); float* Gtot = (float*)((unsigned char*)P.out + OUT_GTOT);
    f32x4 sacc[8];
#pragma unroll
    for (int kb = 0; kb < 8; ++kb) sacc[kb] = (f32x4){0.f, 0.f, 0.f, 0.f};
    float Gseg = 0.f;
    float Lr[8]; bf16_t qr[8], vr[8];
    {   const size_t o = (row00 + 8 * tg) * 1024 + colh + d;
#pragma unroll
        for (int i = 0; i < 8; ++i) { Lr[i] = P.Logf[o + (size_t)i * 1024]; qr[i] = P.Qh[o + (size_t)i * 1024]; vr[i] = P.Vh[o + (size_t)i * 1024]; } }
    LAS float* TT = (LAS float*)(lds + O_TT);
    for (int n = 0; n < 16; ++n) {
        LAS unsigned char* sb = lds + (n & 1) * SETB;
        const size_t row0 = row00 + (size_t)n * 32;
        float g[8]; g[0] = Lr[0];
#pragma unroll
        for (int i = 1; i < 8; ++i) g[i] = g[i - 1] + Lr[i];
        TT[tg * 128 + d] = g[7];
        __syncthreads();
        {
            const float t0 = TT[d], t1 = TT[128 + d], t2 = TT[256 + d], t3 = TT[384 + d];
            const float pre = tg == 0 ? 0.f : tg == 1 ? t0 : tg == 2 ? t0 + t1 : (t0 + t1) + t2;
            const float Gref = t0 + t1, Glast = (t0 + t1) + (t2 + t3);
            const float eRef = ex2(Gref), eLR = ex2(Glast - Gref), eSeg = ex2(Gseg);
            float kd[8];
#pragma unroll
            for (int i = 0; i < 8; ++i) {
                const int t = 8 * tg + i; const float G = pre + g[i];
                const float kk = 1.f - ex2(Lr[i]), e1 = ex2(G - Gref), e2 = __builtin_amdgcn_rcpf(e1);
                const float qt = bf2f(qr[i]) * e1, kt = kk * e2, qd = qt * eRef;
                kd[i] = kt * eLR;
                *(LAS bf16_t*)(sb + O_QT + t * 272 + d * 2) = (bf16_t)cvtpk_s(qt, 0.f);
                *(LAS bf16_t*)(sb + O_KT + t * 272 + d * 2) = (bf16_t)cvtpk_s(kt, 0.f);
                *(LAS bf16_t*)(sb + O_QD + t * 272 + d * 2) = (bf16_t)cvtpk_s(qd, 0.f);
                Qcum[(row0 + t) * 1024 + colh + d] = (bf16_t)cvtpk_s(qd * eSeg, 0.f);
            }
            u32x4 kw = {cvtpk_s(kd[0], kd[1]), cvtpk_s(kd[2], kd[3]), cvtpk_s(kd[4], kd[5]), cvtpk_s(kd[6], kd[7])};
            u32x4 vw = {(unsigned)vr[0] | ((unsigned)vr[1] << 16), (unsigned)vr[2] | ((unsigned)vr[3] << 16), (unsigned)vr[4] | ((unsigned)vr[5] << 16), (unsigned)vr[6] | ((unsigned)vr[7] << 16)};
            *(LAS u32x4*)(sb + O_KDT + d * 80 + tg * 16) = kw;
            *(LAS u32x4*)(sb + O_VT + d * 80 + tg * 16) = vw;
            if (tg == 0) *(LAS float*)(sb + O_DL + d * 4) = ex2(Glast);
            Gseg += Glast;
        }
        if (n + 1 < 16) {
            const size_t o = (row0 + 32 + 8 * tg) * 1024 + colh + d;
#pragma unroll
            for (int i = 0; i < 8; ++i) { Lr[i] = P.Logf[o + (size_t)i * 1024]; qr[i] = P.Qh[o + (size_t)i * 1024]; vr[i] = P.Vh[o + (size_t)i * 1024]; }
        }
        __syncthreads();
        if (wave < 4) {
            const int jb = wave >> 1, ib = wave & 1;
            f32x4 xa = (f32x4){0.f, 0.f, 0.f, 0.f};
            if (!(jb == 1 && ib == 0)) {
#pragma unroll
                for (int s = 0; s < 4; ++s) {
                    const bf16x8 af = *(const LAS bf16x8*)(sb + O_KT + (16 * jb + fr) * 272 + 64 * s + 16 * fq);
                    const bf16x8 bf = *(const LAS bf16x8*)(sb + O_QT + (16 * ib + fr) * 272 + 64 * s + 16 * fq);
                    xa = HG_MFMA(af, bf, xa);
                }
            }
            const int i = 16 * ib + fr, j0 = 16 * jb + 4 * fq;
            u32x2 w; w.x = cvtpk_s(j0 <= i ? xa[0] : 0.f, j0 + 1 <= i ? xa[1] : 0.f); w.y = cvtpk_s(j0 + 2 <= i ? xa[2] : 0.f, j0 + 3 <= i ? xa[3] : 0.f);
            *(LAS u32x2*)(sb + O_XT + i * 80 + 32 * jb + 8 * fq) = w;
        }
        f32x4 oacc[2] = {(f32x4){0.f, 0.f, 0.f, 0.f}, (f32x4){0.f, 0.f, 0.f, 0.f}};
#pragma unroll
        for (int s = 0; s < 4; ++s) {
            const u32x4 aw = {cvtpk_s(sacc[2 * s][0], sacc[2 * s][1]), cvtpk_s(sacc[2 * s][2], sacc[2 * s][3]), cvtpk_s(sacc[2 * s + 1][0], sacc[2 * s + 1][1]), cvtpk_s(sacc[2 * s + 1][2], sacc[2 * s + 1][3])};
            const bf16x8 af = __builtin_bit_cast(bf16x8, aw);
#pragma unroll
            for (int ib = 0; ib < 2; ++ib) {
                const LAS unsigned char* qp = sb + O_QD + (16 * ib + fr) * 272 + 64 * s + 8 * fq;
                const s16x4 lo = *(const LAS s16x4*)qp, hi = *(const LAS s16x4*)(qp + 32);
                const bf16x8 bf = __builtin_shufflevector(lo, hi, 0, 1, 2, 3, 4, 5, 6, 7);
                oacc[ib] = HG_MFMA(af, bf, oacc[ib]);
            }
        }
        const bf16x8 vf = *(const LAS bf16x8*)(sb + O_VT + (16 * wave + fr) * 80 + 16 * fq);
#pragma unroll
        for (int kb = 0; kb < 8; ++kb) {
            const f32x4 dl = *(const LAS f32x4*)(sb + O_DL + (16 * kb + 4 * fq) * 4);
            const bf16x8 af = *(const LAS bf16x8*)(sb + O_KDT + (16 * kb + fr) * 80 + 16 * fq);
            sacc[kb] = HG_MFMA(af, vf, sacc[kb] * dl);
        }
        __syncthreads();
#pragma unroll
        for (int ib = 0; ib < 2; ++ib) {
            const bf16x8 xf = *(const LAS bf16x8*)(sb + O_XT + (16 * ib + fr) * 80 + 16 * fq);
            oacc[ib] = HG_MFMA(vf, xf, oacc[ib]);
            *(f32x4*)(Oloc + (row0 + 16 * ib + fr) * 1024 + colh + 16 * wave + 4 * fq) = oacc[ib];
        }
    }
#pragma unroll
    for (int kb = 0; kb < 8; ++kb) *(f32x4*)(Sloc + ((((size_t)item * 8 + wave) * 8 + kb) * 64 + lane) * 4) = sacc[kb];
    if (tg == 0) Gtot[item * 128 + d] = Gseg;
    __syncthreads();
}
__device__ __forceinline__ void hgrn_fix_item(const Ptrs& P, int item, LAS unsigned char* lds, int tid, int lane, int wave) {
    using namespace hg;
    const int b = item >> 6, h = (item >> 3) & 7, seg = item & 7, fr = lane & 15, fq = lane >> 4;
    const size_t row00 = (size_t)b * S + (size_t)seg * 512;
    const int colw = h * 128 + 16 * wave + 4 * fq;
    const float* Oloc = P.out; const bf16_t* Qcum = (const bf16_t*)((const unsigned char*)P.out + OUT_QCUM); const float* Sloc = (const float*)((const unsigned char*)P.out + OUT_SLOC); const float* Gtot = (const float*)((const unsigned char*)P.out + OUT_GTOT);
    const int trow = tid >> 4, tcol = (tid & 15) * 8;
    u32x4 pq; f32x4 po[2]; u32x2 pg[2];
#define HG_FETCH(n_) do { if (seg > 0) pq = *(const u32x4*)(Qcum + (row00 + (size_t)(n_) * 32 + trow) * 1024 + h * 128 + tcol); \
        _Pragma("unroll") for (int ib = 0; ib < 2; ++ib) { const size_t row = row00 + (size_t)(n_) * 32 + 16 * ib + fr; po[ib] = *(const f32x4*)(Oloc + row * 1024 + colw); pg[ib] = *(const u32x2*)(P.Gh + row * 1024 + colw); } } while (0)
    HG_FETCH(0);
    f32x4 sacc[8];
#pragma unroll
    for (int kb = 0; kb < 8; ++kb) sacc[kb] = (f32x4){0.f, 0.f, 0.f, 0.f};
    if (seg > 0) {
        f32x4 gl[8], sl[8];
#define HG_SFETCH(itp_) do { _Pragma("unroll") for (int kb = 0; kb < 8; ++kb) { gl[kb] = *(const f32x4*)(Gtot + (itp_) * 128 + 16 * kb + 4 * fq); sl[kb] = *(const f32x4*)(Sloc + ((((size_t)(itp_) * 8 + wave) * 8 + kb) * 64 + lane) * 4); } } while (0)
        HG_SFETCH(item - seg);
        for (int sp = 0; sp < seg; ++sp) {
            f32x4 cg[8], cs[8];
#pragma unroll
            for (int kb = 0; kb < 8; ++kb) { cg[kb] = gl[kb]; cs[kb] = sl[kb]; }
            if (sp + 1 < seg) HG_SFETCH(item - seg + sp + 1);
#pragma unroll
            for (int kb = 0; kb < 8; ++kb) { f32x4 dl; dl[0] = ex2(cg[kb][0]); dl[1] = ex2(cg[kb][1]); dl[2] = ex2(cg[kb][2]); dl[3] = ex2(cg[kb][3]); sacc[kb] = sacc[kb] * dl + cs[kb]; }
        }
#undef HG_SFETCH
    }
    bf16x8 af[4];
#pragma unroll
    for (int s = 0; s < 4; ++s) { const u32x4 aw = {cvtpk_s(sacc[2 * s][0], sacc[2 * s][1]), cvtpk_s(sacc[2 * s][2], sacc[2 * s][3]), cvtpk_s(sacc[2 * s + 1][0], sacc[2 * s + 1][1]), cvtpk_s(sacc[2 * s + 1][2], sacc[2 * s + 1][3])};
        af[s] = __builtin_bit_cast(bf16x8, aw); }
    const f32x4 nw = *(const f32x4*)(P.hg_norm_w + 16 * wave + 4 * fq);
    LAS float* red = (LAS float*)(lds + O_RED);
    LAS unsigned char* qt = lds + 4096;
    f32x4 o_prev[2]; u32x2 g_prev[2]; o_prev[0] = o_prev[1] = (f32x4){0.f, 0.f, 0.f, 0.f}; g_prev[0] = g_prev[1] = (u32x2){0u, 0u};
#define HG_FINISH(n_) do { _Pragma("unroll") for (int ib = 0; ib < 2; ++ib) { const size_t row = row00 + (size_t)(n_) * 32 + 16 * ib + fr; float tot = 0.f; \
        _Pragma("unroll") for (int w = 0; w < 8; ++w) tot += red[((((n_) & 1) * 8 + w) * 32) + 16 * ib + fr]; \
        const float rs = rsqrtf(tot * (1.f / 128.f) + RMS_EPS); const f32x4 y = o_prev[ib] * rs * nw; u32x2 ow; \
        ow.x = cvtpk_s(y[0] * __uint_as_float(g_prev[ib].x << 16), y[1] * __uint_as_float(g_prev[ib].x & 0xffff0000u)); ow.y = cvtpk_s(y[2] * __uint_as_float(g_prev[ib].y << 16), y[3] * __uint_as_float(g_prev[ib].y & 0xffff0000u)); \
        *(u32x2*)(P.MIX + row * D + colw) = ow; } } while (0)
    for (int n = 0; n < 16; ++n) {
        LAS unsigned char* tb = qt + (n & 1) * 8704;
        if (seg > 0) *(LAS u32x4*)(tb + trow * 272 + tcol * 2) = pq;
        f32x4 o[2]; u32x2 gg[2];
#pragma unroll
        for (int ib = 0; ib < 2; ++ib) { o[ib] = po[ib]; gg[ib] = pg[ib]; }
        if (n + 1 < 16) HG_FETCH(n + 1);
        __syncthreads();
#pragma unroll
        for (int ib = 0; ib < 2; ++ib) {
            if (seg > 0) {
#pragma unroll
                for (int s = 0; s < 4; ++s) { const LAS unsigned char* qp = tb + (16 * ib + fr) * 272 + 64 * s + 8 * fq;
                    const s16x4 lo = *(const LAS s16x4*)qp, hi = *(const LAS s16x4*)(qp + 32);
                    o[ib] = HG_MFMA(af[s], __builtin_shufflevector(lo, hi, 0, 1, 2, 3, 4, 5, 6, 7), o[ib]); }
            }
            float ss = (o[ib][0] * o[ib][0] + o[ib][1] * o[ib][1]) + (o[ib][2] * o[ib][2] + o[ib][3] * o[ib][3]);
            ss += __shfl_xor(ss, 16); ss += __shfl_xor(ss, 32);
            if (fq == 0) red[((n & 1) * 8 + wave) * 32 + 16 * ib + fr] = ss;
        }
        if (n > 0) HG_FINISH(n - 1);
#pragma unroll
        for (int ib = 0; ib < 2; ++ib) { o_prev[ib] = o[ib]; g_prev[ib] = gg[ib]; }
    }
    __syncthreads();
    HG_FINISH(15);
#undef HG_FINISH
#undef HG_FETCH
    __syncthreads();
}

typedef attn::BlockRef<attn::bf16, attn::bf16> ARef;
__device__ __forceinline__ ARef attn_ref(const Ptrs& P, int L, int pass) {
    const int x = L & 7, k = (L >> 3) & 31, rd = L >> 8, g = x * 4 + rd * 2 + (k >> 4), b = g >> 3, hh = g & 7, idx = k & 15, vh = idx & 1, pair = idx >> 1;
    const int qb = pass ? 15 - pair : pair;
    ARef r; const size_t row0 = (size_t)b * S + (size_t)qb * 256;
    r.Q = (const attn::bf16*)P.Qa + row0 * 1024 + hh * 128;
    r.K = (const attn::bf16*)P.Ka + (size_t)b * S * 1024 + hh * 128;
    r.V = (const attn::bf16*)P.Va + (size_t)b * S * 1024 + (hh >> 1) * 256 + vh * 128;
    r.O = (attn::bf16*)((hh & 1) ? P.O2 : P.O1) + row0 * 1024 + (hh >> 1) * 256 + vh * 128;
    r.P0 = qb * 256;
    return r;
}
__device__ __forceinline__ void p3_attention(const Ptrs& P, unsigned char* lds, const int tid) {
    const int G = gridDim.x, bid = blockIdx.x;
    if (bid >= 512) return;
    const int nblk = 2 * ((512 - bid + G - 1) / G);
    ARef cur = attn_ref(P, bid, 0);
    attn::Seam<attn::bf16> Sm;
    attn::causal_swa_prime<attn::bf16, attn::bf16>(cur, S, (char*)lds, Sm, tid);
    for (int q = 0; q < nblk; ++q) {
        const bool last = (q + 1 == nblk);
        const ARef nxt = last ? cur : attn_ref(P, bid + ((q + 1) >> 1) * G, (q + 1) & 1);
        attn::causal_swa_block<attn::bf16, attn::bf16>(cur, nxt, S, S, (char*)lds, Sm, tid);
        cur = nxt;
    }
}
__device__ __forceinline__ void p4_attn_combine(const Ptrs& P, int lane, int wave) {
    const float lam = P.lam[0];
    const f32x4 w = *(const f32x4*)(P.subln_w + 4 * lane);
    for (int row = blockIdx.x * NWAVES + wave; row < M; row += gridDim.x * NWAVES) {
#pragma unroll
        for (int h = 0; h < 4; ++h) {
            const uint2 a = *(const uint2*)(P.O1 + (size_t)row * 1024 + h * 256 + 4 * lane), b2 = *(const uint2*)(P.O2 + (size_t)row * 1024 + h * 256 + 4 * lane);
            float y[4];
            y[0] = __uint_as_float(a.x << 16) - lam * __uint_as_float(b2.x << 16); y[1] = __uint_as_float(a.x & 0xffff0000u) - lam * __uint_as_float(b2.x & 0xffff0000u);
            y[2] = __uint_as_float(a.y << 16) - lam * __uint_as_float(b2.y << 16); y[3] = __uint_as_float(a.y & 0xffff0000u) - lam * __uint_as_float(b2.y & 0xffff0000u);
            const float ss = wave_sum((y[0] * y[0] + y[1] * y[1]) + (y[2] * y[2] + y[3] * y[3]));
            const float rs = rsqrtf(ss * (1.f / 256.f) + RMS_EPS) * (1.f - LAMBDA_INIT);
            uint2 o; o.x = pk2(y[0] * rs * w[0], y[1] * rs * w[1]); o.y = pk2(y[2] * rs * w[2], y[3] * rs * w[3]);
            *(uint2*)(P.MIX + (size_t)row * D + 1024 + h * 256 + 4 * lane) = o;
        }
    }
}
__device__ __forceinline__ void p3_mixers(const Ptrs& P, unsigned char* lds, int tid, int lane, int wave) {
    REPS(10) for (int it = blockIdx.x; it < 256; it += gridDim.x) hgrn_local_item(P, it, (LAS unsigned char*)lds, tid, lane, wave);
    p3_attention(P, lds, tid);
}


#define XB_TMO      128
#define XB_XCNT(j)  (256  + 64 * (j))
#define XB_XSUB(j)  (1280 + 64 * (j))
#define XB_XGEN(j)  (2304 + 64 * (j))
#define XB_TOP      3328
#define XB_TOPGEN   3392
#define XCD_BAR_WORDS 3456
#define XB_SPIN_CAP (1u << 18)
__device__ __forceinline__ unsigned xb_ld(unsigned* p)              { return __hip_atomic_load(p, __ATOMIC_RELAXED, __HIP_MEMORY_SCOPE_AGENT); }
__device__ __forceinline__ unsigned xb_add(unsigned* p, unsigned v) { return __hip_atomic_fetch_add(p, v, __ATOMIC_RELAXED, __HIP_MEMORY_SCOPE_AGENT); }
__device__ __forceinline__ unsigned xb_xcc_id() { return (unsigned)__builtin_amdgcn_s_getreg((3 << 11) | 20) & 0xFu; }
#define XB_SPIN(cond, bar) do { unsigned _sp = 0; while (cond) { __builtin_amdgcn_s_sleep(1); \
    if ((++_sp & 255u) == 0u) { if (xb_ld(&(bar)[XB_TMO])) break; if (_sp > XB_SPIN_CAP) { atomicAdd(&(bar)[XB_TMO], 1u); break; } } } } while (0)
__device__ __forceinline__ void xcd_barrier_post(unsigned* bar, int tid) { if (tid == 0) (void)xb_add(&bar[XB_XCNT(xb_xcc_id())], 1u); }
__device__ __forceinline__ void xcd_barrier_complete(unsigned* bar, unsigned x, unsigned& nloc, unsigned& nx) {
    const unsigned G = gridDim.x * gridDim.y * gridDim.z;
    unsigned sum, cnt, mine, sp = 0u;
    for (;;) {
        sum = 0u; cnt = 0u; mine = 0u;
#pragma unroll
        for (unsigned j = 0; j < 16; ++j) { const unsigned c = xb_ld(&bar[XB_XCNT(j)]); sum += c; cnt += (c > 0u) ? 1u : 0u; mine = (j == x) ? c : mine; }
        if (sum == G) break;
        __builtin_amdgcn_s_sleep(1);
        if ((++sp & 255u) == 0u) { if (xb_ld(&bar[XB_TMO])) break; if (sp > XB_SPIN_CAP) { atomicAdd(&bar[XB_TMO], 1u); break; } }
    }
    nloc = mine > 0u ? mine : 1u; nx = cnt > 0u ? cnt : 1u;
}
__device__ __forceinline__ void xcd_barrier(unsigned* bar, volatile LAS unsigned* st, int tid) {
    asm volatile("s_waitcnt vmcnt(0)" ::: "memory");
    __syncthreads();
    if (tid == 0) {
        const unsigned x = xb_xcc_id();
        __builtin_amdgcn_s_waitcnt(0);
        unsigned nloc = st[0], nx = st[1];
        if (nloc == 0u) { xcd_barrier_complete(bar, x, nloc, nx); st[0] = nloc; st[1] = nx; }
        const unsigned old = xb_add(&bar[XB_XSUB(x)], 1u);
        const unsigned gen = old / nloc;
        if (old + 1u == (gen + 1u) * nloc) {
            __builtin_amdgcn_fence(__ATOMIC_RELEASE, "agent");
            asm volatile("s_waitcnt vmcnt(0)" ::: "memory");
            const unsigned og = xb_add(&bar[XB_TOP], 1u);
            const unsigned tg = og / nx;
            if (og + 1u == (tg + 1u) * nx) xb_add(&bar[XB_TOPGEN], 1u);
            else XB_SPIN(xb_ld(&bar[XB_TOPGEN]) == tg, bar);
            __builtin_amdgcn_fence(__ATOMIC_ACQUIRE, "agent");
            xb_add(&bar[XB_XGEN(x)], 1u);
            asm volatile("s_waitcnt vmcnt(0)" ::: "memory");
        } else {
            XB_SPIN(xb_ld(&bar[XB_XGEN(x)]) == gen, bar);
            __builtin_amdgcn_fence(__ATOMIC_ACQUIRE, "agent");
            asm volatile("s_waitcnt vmcnt(0)" ::: "memory");
        }
    }
    __syncthreads();
}

__device__ __forceinline__ int lane_id_asm() { int l; asm volatile("v_mbcnt_lo_u32_b32 %0, -1, 0\n\tv_mbcnt_hi_u32_b32 %0, -1, %0" : "=v"(l)); return l; }
struct Args { const void* in[21]; float* out; unsigned char* ws; int ph_lo, ph_hi; };
constexpr int NPHASE = 10;

__device__ __forceinline__ Ptrs mk_ptrs(const Args& a) {
    Ptrs P;
    P.x = (const float*)a.in[0]; P.c = (const float*)a.in[1]; P.positions = (const int*)a.in[2]; P.w_ada = (const float*)a.in[3]; P.b_ada = (const float*)a.in[4]; P.w_in = (const float*)a.in[5];
    P.lb_logits = (const float*)a.in[6]; P.hg_norm_w = (const float*)a.in[7]; P.lq1 = (const float*)a.in[8]; P.lk1 = (const float*)a.in[9]; P.lq2 = (const float*)a.in[10]; P.lk2 = (const float*)a.in[11];
    P.subln_w = (const float*)a.in[12]; P.w_out = (const float*)a.in[13]; P.ln1_g = (const float*)a.in[14]; P.ln1_b = (const float*)a.in[15]; P.w_gate = (const float*)a.in[16]; P.w_up = (const float*)a.in[17];
    P.w_down = (const float*)a.in[18]; P.ln2_g = (const float*)a.in[19]; P.ln2_b = (const float*)a.in[20];
    P.out = a.out; unsigned char* ws = a.ws;
    P.mod = (float*)(ws + OFF_MOD); P.lbv = (float*)(ws + OFF_LB); P.lam = (float*)(ws + OFF_LAM); P.cosT = (float*)(ws + OFF_COS); P.sinT = (float*)(ws + OFF_SIN);
    P.WinT = (bf16_t*)(ws + OFF_WIN); P.WoT = (bf16_t*)(ws + OFF_WO); P.WguT = (bf16_t*)(ws + OFF_WGU); P.WdT = (bf16_t*)(ws + OFF_WD);
    P.U = (bf16_t*)(ws + OFF_U); P.MIX = (bf16_t*)(ws + OFF_MIX); P.Qh = (bf16_t*)(ws + OFF_QH); P.Vh = (bf16_t*)(ws + OFF_VH); P.Gh = (bf16_t*)(ws + OFF_GH); P.Logf = (float*)(ws + OFF_LOGF);
    P.Qa = (bf16_t*)(ws + OFF_QA); P.Ka = (bf16_t*)(ws + OFF_KA); P.Va = (bf16_t*)(ws + OFF_VA); P.T1 = (float*)(ws + OFF_T1); P.H1 = (float*)(ws + OFF_H1); P.Hff = (bf16_t*)(ws + OFF_HFF); P.O1 = (bf16_t*)(ws + OFF_O1); P.O2 = (bf16_t*)(ws + OFF_O2);
    return P;
}
__global__ void __launch_bounds__(NTHREADS, 2) fwd_kernel(Args a) {
    extern __shared__ __attribute__((aligned(16))) unsigned char lds[];
    cg::grid_group grid = cg::this_grid();
    const int wave = __builtin_amdgcn_readfirstlane(threadIdx.x >> 6);
    LAS unsigned char* ldsl = (LAS unsigned char*)lds;
    volatile LAS unsigned* bst = (volatile LAS unsigned*)(ldsl + LDS_BYTES - 64);
    { const int l0 = lane_id_asm(); if (wave == 0 && l0 < 2) bst[l0] = 0u; }
    __syncthreads();
    const int lo = a.ph_lo, hi = a.ph_hi;
#define IN(k) (lo <= (k) && (k) < hi)
#define SEAM(k) do { if (IN(k) && IN((k) + 1)) { const int lane_ = lane_id_asm(); xcd_barrier((unsigned*)(a.ws + OFF_BAR), bst, wave * 64 + lane_); } } while (0)
    if (IN(0) && blockIdx.x == 0) { const int lane_ = lane_id_asm(); unsigned* bw = (unsigned*)(a.ws + OFF_BAR); for (int i = wave * 64 + lane_; i < XCD_BAR_WORDS; i += NTHREADS) bw[i] = 0u; }
    if (IN(0)) REPS(0) { const Ptrs P = mk_ptrs(a); const int lane = lane_id_asm(), tid = wave * 64 + lane; p0_prologue(P, ldsl, tid, lane, wave); }
    if (IN(0) && IN(1)) { grid.sync(); { const int lane_ = lane_id_asm(); xcd_barrier_post((unsigned*)(a.ws + OFF_BAR), wave * 64 + lane_); } }
    if (IN(1)) REPS(1) { const Ptrs P = mk_ptrs(a); const int lane = lane_id_asm(), tid = wave * 64 + lane; p1_ln_mod(P, lane, wave); } SEAM(1);
    if (IN(2)) REPS(2) { const Ptrs P = mk_ptrs(a); const int lane = lane_id_asm(), tid = wave * 64 + lane;
        pg8::Gemm g{P.U, P.WinT, M, NIN, D}; pg8::StaticOrder So; So.init(M, NIN, gridDim.x, blockIdx.x);
        pg8::EpiAdapt<Epi1> E{Epi1{P.Qh, P.Vh, P.Gh, P.Qa, P.Ka, P.Va, P.Logf, P.lbv, P.positions}};
        pg8::gemm_phase<pg8::EpiAdapt<Epi1>, pg8::StaticOrder, true, true>(ldsl, g, So, E, tid);
    } SEAM(2);
    if (IN(3)) REPS(3) { const Ptrs P = mk_ptrs(a); const int lane = lane_id_asm(), tid = wave * 64 + lane; p3_mixers(P, lds, tid, lane, wave); } SEAM(3);
    if (IN(4)) REPS(4) { const Ptrs P = mk_ptrs(a); const int lane = lane_id_asm(), tid = wave * 64 + lane; REPS(11) for (int it = blockIdx.x; it < 256; it += gridDim.x) hgrn_fix_item(P, it, ldsl, tid, lane, wave); p4_attn_combine(P, lane, wave); } SEAM(4);
    if (IN(5)) REPS(5) { const Ptrs P = mk_ptrs(a); const int lane = lane_id_asm(), tid = wave * 64 + lane;
        pg8::Gemm g{P.MIX, P.WoT, M, D, D}; pg8::StaticOrder So; So.init(M, D, gridDim.x, blockIdx.x);
        pg8::EpiAdapt<EpiRes> E{EpiRes{P.x, P.mod + 2 * D, P.T1}};
        pg8::gemm_phase<pg8::EpiAdapt<EpiRes>, pg8::StaticOrder, true, true>(ldsl, g, So, E, tid);
    } SEAM(5);
    if (IN(6)) REPS(6) { const Ptrs P = mk_ptrs(a); const int lane = lane_id_asm(), tid = wave * 64 + lane; p5_ln1(P, lane, wave); } SEAM(6);
    if (IN(7)) REPS(7) { const Ptrs P = mk_ptrs(a); const int lane = lane_id_asm(), tid = wave * 64 + lane;
        pg8::Gemm g{P.U, P.WguT, M, NGU, D}; pg8::StaticOrder So; So.init(M, NGU, gridDim.x, blockIdx.x);
        pg8::EpiAdapt<EpiSwiglu> E{EpiSwiglu{P.Hff}};
        pg8::gemm_phase<pg8::EpiAdapt<EpiSwiglu>, pg8::StaticOrder, true, true>(ldsl, g, So, E, tid);
    } SEAM(7);
    if (IN(8)) REPS(8) { const Ptrs P = mk_ptrs(a); const int lane = lane_id_asm(), tid = wave * 64 + lane;
        pg8::Gemm g{P.Hff, P.WdT, M, D, DFF}; pg8::StaticOrder So; So.init(M, D, gridDim.x, blockIdx.x);
        pg8::EpiAdapt<EpiRes> E{EpiRes{P.H1, P.mod + 5 * D, P.out}};
        pg8::gemm_phase<pg8::EpiAdapt<EpiRes>, pg8::StaticOrder, true, true>(ldsl, g, So, E, tid);
    } SEAM(8);
    if (IN(9)) { const Ptrs P = mk_ptrs(a); const int lane = lane_id_asm(), tid = wave * 64 + lane; p8_ln_final(P, lane, wave); }
#undef IN
#undef SEAM
}

#ifndef MK_N_LAUNCHES
#define MK_N_LAUNCHES 1
#endif
extern "C" void kernel_launch(void* const* d_in, const int* in_sizes, int n_in, void* d_out, int out_size, void* d_ws, size_t ws_size, hipStream_t stream) {
    static int grid = 0;
    if (grid == 0) {
        if (n_in != 21 || in_sizes[0] != M * D || out_size != M * D || ws_size < WS_NEED) { fprintf(stderr, "kernel_launch: unexpected shapes (n_in %d, in0 %d, out %d, ws %zu)\n", n_in, n_in > 0 ? in_sizes[0] : -1, out_size, ws_size); grid = -1; return; }
        int dev = 0, cus = 0, per_cu = 0;
        if (hipGetDevice(&dev) != hipSuccess || hipDeviceGetAttribute(&cus, hipDeviceAttributeMultiprocessorCount, dev) != hipSuccess) { fprintf(stderr, "kernel_launch: device query failed\n"); grid = -1; return; }
        if (hipFuncSetAttribute((const void*)fwd_kernel, hipFuncAttributeMaxDynamicSharedMemorySize, LDS_BYTES) != hipSuccess) { fprintf(stderr, "kernel_launch: hipFuncSetAttribute failed\n"); grid = -1; return; }
        if (hipOccupancyMaxActiveBlocksPerMultiprocessor(&per_cu, (const void*)fwd_kernel, NTHREADS, LDS_BYTES) != hipSuccess || per_cu < 1) { fprintf(stderr, "kernel_launch: occupancy query says %d blocks per CU\n", per_cu); (void)hipGetLastError(); per_cu = 1; }
        grid = cus * (per_cu < 1 ? 1 : 1);
    }
    if (grid < 0) return;
    Args a{};
    for (int i = 0; i < 21; ++i) a.in[i] = d_in[i];
    a.out = (float*)d_out; a.ws = (unsigned char*)d_ws;
#if MK_N_LAUNCHES == 1
    a.ph_lo = 0; a.ph_hi = NPHASE;
    void* args[] = {&a};
    hipError_t e = hipLaunchCooperativeKernel((const void*)fwd_kernel, dim3(grid), dim3(NTHREADS), args, LDS_BYTES, stream);
    if (e != hipSuccess) fprintf(stderr, "kernel_launch: cooperative launch failed: %s (grid %d)\n", hipGetErrorString(e), grid);
#else
    for (int p = 0; p < NPHASE; ++p) { a.ph_lo = p; a.ph_hi = p + 1; hipLaunchKernelGGL(fwd_kernel, dim3(grid), dim3(NTHREADS), LDS_BYTES, stream, a); }
#endif
}
```
